# Optimizing an MI355X kernel written in HIP

```python
import jax, jax.numpy as jnp
from jax import lax
import numpy as np

D_MODEL = 2048
BATCH = 2
SEQ = 8192
DEPTH = 4

CHUNK = 64
MEM_LEN = 256
HEAD_DIM = 128
MIX_WIDTH = D_MODEL
HALF_WIDTH = MIX_WIDTH // 2
POOL_GROUPS = 4
POOL_WINDOWS = (2, 4, 8, 16)
POOL_GROUP_DIM = HALF_WIDTH // POOL_GROUPS
DSA_HEADS = HALF_WIDTH // HEAD_DIM
IDX_HEADS = 16
IDX_DIM = 64
DSA_TOPK_MAX = 256
DSA_BLOCK = 64
CONV_WIDTH = 3
CONV_DIM = HALF_WIDTH
FOX_HEADS = HALF_WIDTH // HEAD_DIM
FOX_BLOCK = 128
FORGET_BIAS_INIT = 2.0
XA_HEADS = 4
XA_WIDTH = XA_HEADS * HEAD_DIM
FFN_HIDDEN = -(-(8 * D_MODEL) // (3 * 256)) * 256
ROPE_THETA = 500000.0
ROPE_FRACTION = 4
LN_EPS = 1e-5
ALPHA = (2 * DEPTH) ** 0.25
BETA = (8 * DEPTH) ** -0.25
N_EVEN = (DEPTH + 1) // 2
N_ODD = DEPTH // 2
EV_SIZES = (HALF_WIDTH, HALF_WIDTH, HALF_WIDTH, HALF_WIDTH, IDX_HEADS * IDX_DIM, IDX_DIM, IDX_HEADS)
EV_IN = sum(EV_SIZES)
OD_SIZES = (CONV_DIM, CONV_DIM, CONV_DIM, HALF_WIDTH, HALF_WIDTH, HALF_WIDTH, FOX_HEADS)
OD_IN = sum(OD_SIZES)

kernel_name = "hybrid_pool_dsa_conv_fox_deepnorm_trunk"


def split_cols(h, sizes):
    offs, acc = [], 0
    for s in sizes[:-1]:
        acc += s
        offs.append(acc)
    return jnp.split(h, offs, axis=-1)


def layer_norm(x, g, b):
    xf = x.astype(jnp.float32)
    mu = jnp.mean(xf, axis=-1, keepdims=True)
    var = jnp.mean(jnp.square(xf - mu), axis=-1, keepdims=True)
    return ((xf - mu) * lax.rsqrt(var + LN_EPS) * g + b).astype(x.dtype)


def partial_rotary(x, positions):
    dh = x.shape[-1]
    rot = dh // ROPE_FRACTION
    half = rot // 2
    inv_freq = jnp.power(ROPE_THETA, -(jnp.arange(half, dtype=jnp.float32) * 2.0 / rot))
    ang = positions.astype(jnp.float32)[..., None] * inv_freq
    cos = jnp.cos(ang)[:, :, None, :]
    sin = jnp.sin(ang)[:, :, None, :]
    x1 = x[..., :half].astype(jnp.float32)
    x2 = x[..., half:rot].astype(jnp.float32)
    xr = jnp.concatenate([x1 * cos - x2 * sin, x2 * cos + x1 * sin], axis=-1).astype(x.dtype)
    return jnp.concatenate([xr, x[..., rot:]], axis=-1)


def pool_mixer(u, w_groups, scale):
    B, S, C = u.shape
    uf = u.astype(jnp.float32)
    cs = jnp.cumsum(uf, axis=1)
    cnt = jnp.arange(1, S + 1, dtype=jnp.float32)[None, :, None]
    ug = jnp.split(uf, POOL_GROUPS, axis=-1)
    cg = jnp.split(cs, POOL_GROUPS, axis=-1)
    outs = []
    for w, u_g, c_g in zip(POOL_WINDOWS, ug, cg):
        lag = jnp.pad(c_g, ((0, 0), (w, 0), (0, 0)))[:, :S]
        outs.append((c_g - lag) / jnp.minimum(cnt, float(w)) - u_g)
    d = jnp.stack(outs, axis=2).astype(u.dtype)
    y = jnp.einsum('bsgc,gcd->bsgd', d, w_groups)
    return y.reshape(B, S, C) * scale


def dsa_attention(q, k, v, qi, ki, wi):
    B, S, H, Dh = q.shape
    topk = min(DSA_TOPK_MAX, S // 4)
    nblk = S // DSA_BLOCK
    s_idx = jnp.arange(S, dtype=jnp.int32)
    scale = Dh ** -0.5
    gather = jax.vmap(lambda a, i: a[i])

    def block(args):
        qb, qib, wib, t0 = args
        t = t0 + jnp.arange(DSA_BLOCK, dtype=jnp.int32)
        il = jnp.einsum('bthd,bsd->bths', qib, ki) * (IDX_DIM ** -0.5)
        score = jnp.einsum('bths,bth->bts', jax.nn.relu(il), wib).astype(jnp.float32)
        admissible = (s_idx[None, :] // CHUNK) <= (t[:, None] // CHUNK)
        score = jnp.where(admissible[None], score, -jnp.inf)
        _, idx = lax.top_k(score, topk)
        valid = (idx // CHUNK) <= (t // CHUNK)[None, :, None]
        ks = gather(k, idx)
        vs = gather(v, idx)
        logits = jnp.einsum('bthd,btkhd->bthk', qb, ks).astype(jnp.float32) * scale
        logits = jnp.where(valid[:, :, None, :], logits, -jnp.inf)
        p = jax.nn.softmax(logits, axis=-1).astype(v.dtype)
        return jnp.einsum('bthk,btkhd->bthd', p, vs)

    def blocks(a):
        return a.reshape((B, nblk, DSA_BLOCK) + a.shape[2:]).swapaxes(0, 1)

    starts = jnp.arange(nblk, dtype=jnp.int32) * DSA_BLOCK
    out = lax.map(block, (blocks(q), blocks(qi), blocks(wi), starts))
    return out.swapaxes(0, 1).reshape(B, S, H * Dh)


def short_conv(u, w):
    C = u.shape[-1]
    return lax.conv_general_dilated(
        u, w[:, None, :], window_strides=(1,), padding=[(CONV_WIDTH - 1, 0)],
        dimension_numbers=('NWC', 'WIO', 'NWC'), feature_group_count=C)


def fox_attention(q, k, v, log_f):
    B, S, H, Dh = q.shape
    nblk = S // FOX_BLOCK
    Fc = jnp.cumsum(log_f, axis=1).transpose(0, 2, 1)
    s_idx = jnp.arange(S, dtype=jnp.int32)
    scale = Dh ** -0.5

    def block(args):
        qb, Fb, t0 = args
        t = t0 + jnp.arange(FOX_BLOCK, dtype=jnp.int32)
        logits = jnp.einsum('bthd,bshd->bhts', qb, k).astype(jnp.float32) * scale
        logits = logits + Fb[..., None] - Fc[:, :, None, :]
        logits = jnp.where((s_idx[None, :] <= t[:, None])[None, None], logits, -jnp.inf)
        p = jax.nn.softmax(logits, axis=-1).astype(v.dtype)
        return jnp.einsum('bhts,bshd->bthd', p, v)

    qb = q.reshape(B, nblk, FOX_BLOCK, H, Dh).swapaxes(0, 1)
    Fb = Fc.reshape(B, H, nblk, FOX_BLOCK).transpose(2, 0, 1, 3)
    starts = jnp.arange(nblk, dtype=jnp.int32) * FOX_BLOCK
    out = lax.map(block, (qb, Fb, starts))
    return out.swapaxes(0, 1).reshape(B, S, H * Dh)


def even_mixer(x, positions, w_in, pool_w, pool_scale, w_out):
    B, S, _ = x.shape
    h = x @ w_in
    u_pool, q, k, v, qi, ki, wi = split_cols(h, EV_SIZES)
    a = pool_mixer(u_pool, pool_w, pool_scale)
    q = partial_rotary(q.reshape(B, S, DSA_HEADS, HEAD_DIM), positions)
    k = partial_rotary(k.reshape(B, S, DSA_HEADS, HEAD_DIM), positions)
    v = v.reshape(B, S, DSA_HEADS, HEAD_DIM)
    qi = partial_rotary(qi.reshape(B, S, IDX_HEADS, IDX_DIM), positions)
    ki = partial_rotary(ki[:, :, None, :], positions)[:, :, 0]
    wi = wi * (IDX_HEADS ** -0.5)
    b = dsa_attention(q, k, v, qi, ki, wi)
    return jnp.concatenate([a, b], axis=-1) @ w_out


def odd_mixer(x, w_in, conv_w, forget_b, w_out):
    B, S, _ = x.shape
    h = x @ w_in
    u, gate_b, gate_c, q, k, v, f_logit = split_cols(h, OD_SIZES)
    c = gate_b * short_conv(gate_c * u, conv_w)
    log_f = jax.nn.log_sigmoid((f_logit + forget_b).astype(jnp.float32))
    d = fox_attention(q.reshape(B, S, FOX_HEADS, HEAD_DIM), k.reshape(B, S, FOX_HEADS, HEAD_DIM),
                      v.reshape(B, S, FOX_HEADS, HEAD_DIM), log_f)
    return jnp.concatenate([c, d], axis=-1) @ w_out


def memory_cross_attention(x, mem, w_q, w_kv, w_o):
    B, S, _ = x.shape
    M = mem.shape[1]
    q = (x @ w_q).reshape(B, S, XA_HEADS, HEAD_DIM)
    kv = (mem @ w_kv).reshape(B, M, 2, XA_HEADS, HEAD_DIM)
    k, v = kv[:, :, 0], kv[:, :, 1]
    logits = jnp.einsum('bshd,bmhd->bhsm', q, k).astype(jnp.float32) * (HEAD_DIM ** -0.5)
    p = jax.nn.softmax(logits, axis=-1).astype(x.dtype)
    o = jnp.einsum('bhsm,bmhd->bshd', p, v).reshape(B, S, XA_WIDTH)
    return o @ w_o


def swiglu_ffn(x, w_in, w_out):
    gate, up = jnp.split(x @ w_in, 2, axis=-1)
    return (jax.nn.silu(gate) * up) @ w_out


def setup_inputs(seed: int = 0) -> dict:
    key = jax.random.key(seed)
    ks = jax.random.split(key, 20)

    def nrm(k, shape, scale):
        return jax.random.normal(k, shape, jnp.float32) * scale

    x = nrm(ks[0], (BATCH, SEQ, D_MODEL), 1.0)
    mem = nrm(ks[1], (BATCH, MEM_LEN, D_MODEL), 1.0)
    offs = jax.random.randint(ks[2], (BATCH,), 0, 64, dtype=jnp.int32) * CHUNK
    positions = (offs[:, None] + jnp.arange(SEQ, dtype=jnp.int32)[None, :]).astype(jnp.int32)
    return {
        "x": x,
        "mem": mem,
        "positions": positions,
        "ev_w_in": nrm(ks[3], (N_EVEN, D_MODEL, EV_IN), D_MODEL ** -0.5),
        "ev_pool_w": nrm(ks[4], (N_EVEN, POOL_GROUPS, POOL_GROUP_DIM, POOL_GROUP_DIM), POOL_GROUP_DIM ** -0.5),
        "ev_pool_scale": 1.0 + nrm(ks[5], (N_EVEN, HALF_WIDTH), 0.02),
        "ev_w_out": nrm(ks[6], (N_EVEN, MIX_WIDTH, D_MODEL), BETA * MIX_WIDTH ** -0.5),
        "od_w_in": nrm(ks[7], (N_ODD, D_MODEL, OD_IN), D_MODEL ** -0.5),
        "od_conv_w": nrm(ks[8], (N_ODD, CONV_WIDTH, CONV_DIM), CONV_WIDTH ** -0.5),
        "od_forget_b": FORGET_BIAS_INIT + nrm(ks[9], (N_ODD, FOX_HEADS), 0.1),
        "od_w_out": nrm(ks[10], (N_ODD, MIX_WIDTH, D_MODEL), BETA * MIX_WIDTH ** -0.5),
        "ca_w_q": nrm(ks[11], (DEPTH, D_MODEL, XA_WIDTH), D_MODEL ** -0.5),
        "ca_w_kv": nrm(ks[12], (DEPTH, D_MODEL, 2 * XA_WIDTH), D_MODEL ** -0.5),
        "ca_w_o": nrm(ks[13], (DEPTH, XA_WIDTH, D_MODEL), BETA * XA_WIDTH ** -0.5),
        "ffn_w_in": nrm(ks[14], (DEPTH, D_MODEL, 2 * FFN_HIDDEN), D_MODEL ** -0.5),
        "ffn_w_out": nrm(ks[15], (DEPTH, FFN_HIDDEN, D_MODEL), BETA * FFN_HIDDEN ** -0.5),
        "ln_g": 1.0 + nrm(ks[16], (DEPTH, 3, D_MODEL), 0.02),
        "ln_b": nrm(ks[17], (DEPTH, 3, D_MODEL), 0.02),
    }


def reference(x, mem, positions, ev_w_in, ev_pool_w, ev_pool_scale, ev_w_out,
              od_w_in, od_conv_w, od_forget_b, od_w_out,
              ca_w_q, ca_w_kv, ca_w_o, ffn_w_in, ffn_w_out, ln_g, ln_b):
    for i in range(DEPTH):
        j = i // 2
        if i % 2 == 0:
            m = even_mixer(x, positions, ev_w_in[j], ev_pool_w[j], ev_pool_scale[j], ev_w_out[j])
        else:
            m = odd_mixer(x, od_w_in[j], od_conv_w[j], od_forget_b[j], od_w_out[j])
        x = layer_norm(ALPHA * x + m, ln_g[i, 0], ln_b[i, 0])
        x = layer_norm(ALPHA * x + memory_cross_attention(x, mem, ca_w_q[i], ca_w_kv[i], ca_w_o[i]),
                       ln_g[i, 1], ln_b[i, 1])
        x = layer_norm(ALPHA * x + swiglu_ffn(x, ffn_w_in[i], ffn_w_out[i]), ln_g[i, 2], ln_b[i, 2])
    return x
```

```cpp
#include <hip/hip_runtime.h>
#include <hip/hip_cooperative_groups.h>
#include <stdint.h>
#include <stdio.h>
#include <math.h>
namespace cg = cooperative_groups;

#define DI __device__ __forceinline__
typedef unsigned short u16;
typedef unsigned long long u64;
typedef short bf16x8 __attribute__((ext_vector_type(8)));
typedef float f32x16 __attribute__((ext_vector_type(16)));
typedef unsigned u32x4 __attribute__((ext_vector_type(4)));
typedef float f32x4 __attribute__((ext_vector_type(4)));
#define MFMA(a, b, c) __builtin_amdgcn_mfma_f32_32x32x16_bf16((a), (b), (c), 0, 0, 0)

constexpr int S_ = 8192, NTOK = 16384, DM = 2048;
constexpr int HLD = 5376;
constexpr int EV_N = 4352, OD_N = 5376;
constexpr int FFH = 5632;
constexpr float ALPHA_ = 1.6817928305074290f;
constexpr float LOG2E = 1.4426950408889634f;
constexpr int SCB = 2048 * 128 * 129;

constexpr size_t al256(size_t x) { return (x + 255) & ~(size_t)255; }
constexpr size_t SZ_EVIN = (size_t)EV_N * 2048 * 2, SZ_V = (size_t)1024 * 2048 * 2, SZ_SQ = (size_t)2048 * 2048 * 2;
constexpr size_t SZ_POOL = (size_t)4 * 256 * 256 * 2, SZ_ODIN = (size_t)OD_N * 2048 * 2;
constexpr size_t SZ_CA = (size_t)512 * 2048 * 2, SZ_FFIN = (size_t)11264 * 2048 * 2, SZ_FFOUT = (size_t)2048 * FFH * 2;
constexpr size_t O_EVIN = 0;
constexpr size_t O_EVV = O_EVIN + 2 * SZ_EVIN;
constexpr size_t O_EVOUT = O_EVV + 2 * SZ_V;
constexpr size_t O_POOL = O_EVOUT + 2 * SZ_SQ;
constexpr size_t O_ODIN = O_POOL + 2 * SZ_POOL;
constexpr size_t O_ODV = O_ODIN + 2 * SZ_ODIN;
constexpr size_t O_ODOUT = O_ODV + 2 * SZ_V;
constexpr size_t O_CAQ = O_ODOUT + 2 * SZ_SQ;
constexpr size_t O_CAK = O_CAQ + 4 * SZ_CA;
constexpr size_t O_CAV = O_CAK + 4 * SZ_CA;
constexpr size_t O_CAO = O_CAV + 4 * SZ_CA;
constexpr size_t O_FFIN = O_CAO + 4 * SZ_CA;
constexpr size_t O_FFOUT = O_FFIN + 4 * SZ_FFIN;
constexpr size_t O_XB = O_FFOUT + 4 * SZ_FFOUT;
constexpr size_t O_XF = O_XB + (size_t)NTOK * DM * 2;
constexpr size_t O_MEMB = O_XF + (size_t)NTOK * DM * 4;
constexpr size_t O_MEMK = O_MEMB + (size_t)512 * 2048 * 2;
constexpr size_t O_MEMVT = O_MEMK + (size_t)4 * 512 * 512 * 2;
constexpr size_t O_H = O_MEMVT + (size_t)4 * 512 * 512 * 2;
constexpr size_t O_VT = O_H + (size_t)NTOK * HLD * 2;
constexpr size_t O_CAT = O_VT + (size_t)2 * 1024 * S_ * 2;
constexpr size_t O_DP = O_CAT + (size_t)NTOK * DM * 2;
constexpr size_t O_AUX = O_DP + (size_t)NTOK * 1024 * 2;
constexpr size_t O_FC = O_AUX + (size_t)NTOK * 16 * 4;
constexpr size_t O_BM = O_FC + (size_t)16 * S_ * 4;
constexpr size_t O_CQ = O_BM + (size_t)NTOK * 256 * 4;
constexpr size_t O_CO = O_CQ + (size_t)NTOK * 512 * 2;
constexpr size_t O_Y = O_CO + (size_t)NTOK * 512 * 2;
constexpr size_t O_HID = O_Y + (size_t)NTOK * DM * 4;
constexpr size_t O_SC = O_Y;
constexpr size_t O_BAR = O_HID + (size_t)NTOK * FFH * 2;
constexpr size_t O_STATS = O_BAR + 32768;
constexpr size_t WS_TOTAL = O_STATS + (size_t)12 * 64 * 8 * 256 * 8;
constexpr int KN_WORD0 = 8000;
constexpr int CNT_WORD0 = 3456;
static_assert((size_t)2 * SCB * 4 <= (size_t)NTOK * DM * 4 + (size_t)NTOK * FFH * 2, "score alias too small");

constexpr int LDS_BYTES = 131072 + 64 + 1024 + 64;
constexpr int NTHR = 512, NWAVE = 8;
extern __shared__ __attribute__((aligned(1024))) char dynsmem[];

struct Params {
  const float* x; const float* mem; const int* pos;
  const float* ev_w_in; const float* ev_pool_w; const float* ev_pool_scale; const float* ev_w_out;
  const float* od_w_in; const float* od_conv_w; const float* od_forget_b; const float* od_w_out;
  const float* ca_w_q; const float* ca_w_kv; const float* ca_w_o; const float* ffn_w_in; const float* ffn_w_out;
  const float* ln_g; const float* ln_b;
  float* out; char* ws;
};
__constant__ float c_invf32[16] = {1.000000000e+00f, 4.403666027e-01f, 1.939227447e-01f, 8.539710029e-02f, 3.760603093e-02f, 1.656044008e-02f, 7.292664737e-03f, 3.211445995e-03f, 1.414213562e-03f, 6.227724219e-04f, 2.742481757e-04f, 1.207697374e-04f, 5.318295897e-05f, 2.341999896e-05f, 1.031338538e-05f, 4.541670481e-06f};
__constant__ float c_invf16[8] = {1.000000000e+00f, 1.939227447e-01f, 3.760603093e-02f, 7.292664737e-03f, 1.414213562e-03f, 2.742481757e-04f, 5.318295897e-05f, 1.031338538e-05f};

DI unsigned pk2(float a, float b) {
  typedef __bf16 b2 __attribute__((ext_vector_type(2)));
  typedef float f2 __attribute__((ext_vector_type(2)));
  f2 v = {a, b};
  b2 r = __builtin_convertvector(v, b2);
  return __builtin_bit_cast(unsigned, r);
}
DI int opq(int v) { asm volatile("" : "+v"(v)); return v; }
DI int opqs(int v) { asm volatile("" : "+s"(v)); return v; }
#define TID opq((int)threadIdx.x)
#define BID opqs((int)blockIdx.x)
DI float shflx(float v, int m, int lane) { return __int_as_float(__builtin_amdgcn_ds_bpermute((lane ^ m) << 2, __float_as_int(v))); }
DI int shflxi(int v, int m, int lane) { return __builtin_amdgcn_ds_bpermute((lane ^ m) << 2, v); }
DI u16 f2bf(float a) { return (u16)(pk2(a, 0.f) & 0xffffu); }
DI float bf2f(u16 v) { return __uint_as_float(((unsigned)v) << 16); }
DI float bflo(unsigned v) { return __uint_as_float(v << 16); }
DI float bfhi(unsigned v) { return __uint_as_float(v & 0xffff0000u); }

struct CJob { const float* src; int K; int lds; u16* dst; int rows; int n1; int off1; int n2; int off2; int ffn; };

DI CJob get_job(const Params& p, int id) {
  CJob j; j.ffn = 0; j.n2 = 0; j.off2 = 0; j.off1 = 0;
  char* ws = p.ws;
  if (id < 2) {
    j.src = p.ev_w_in + (size_t)id * 2048 * 5200; j.K = 2048; j.lds = 5200; j.dst = (u16*)(ws + O_EVIN + id * SZ_EVIN); j.rows = EV_N;
    j.n1 = 3072; j.off1 = 0; j.n2 = 4176; j.off2 = 1024;
  } else if (id < 4) {
    int l = id - 2; j.src = p.ev_w_in + (size_t)l * 2048 * 5200; j.K = 2048; j.lds = 5200; j.dst = (u16*)(ws + O_EVV + l * SZ_V); j.rows = 1024;
    j.n1 = 1024; j.off1 = 3072;
  } else if (id < 6) {
    int l = id - 4; j.src = p.ev_w_out + (size_t)l * 2048 * 2048; j.K = 2048; j.lds = 2048; j.dst = (u16*)(ws + O_EVOUT + l * SZ_SQ); j.rows = 2048; j.n1 = 2048;
  } else if (id < 14) {
    int l = id - 6; j.src = p.ev_pool_w + (size_t)l * 256 * 256; j.K = 256; j.lds = 256; j.dst = (u16*)(ws + O_POOL) + (size_t)l * 256 * 256; j.rows = 256; j.n1 = 256;
  } else if (id < 16) {
    int l = id - 14; j.src = p.od_w_in + (size_t)l * 2048 * 6152; j.K = 2048; j.lds = 6152; j.dst = (u16*)(ws + O_ODIN + l * SZ_ODIN); j.rows = OD_N;
    j.n1 = 5120; j.off1 = 0; j.n2 = 5128; j.off2 = 1024;
  } else if (id < 18) {
    int l = id - 16; j.src = p.od_w_in + (size_t)l * 2048 * 6152; j.K = 2048; j.lds = 6152; j.dst = (u16*)(ws + O_ODV + l * SZ_V); j.rows = 1024; j.n1 = 1024; j.off1 = 5120;
  } else if (id < 20) {
    int l = id - 18; j.src = p.od_w_out + (size_t)l * 2048 * 2048; j.K = 2048; j.lds = 2048; j.dst = (u16*)(ws + O_ODOUT + l * SZ_SQ); j.rows = 2048; j.n1 = 2048;
  } else if (id < 24) {
    int l = id - 20; j.src = p.ca_w_q + (size_t)l * 2048 * 512; j.K = 2048; j.lds = 512; j.dst = (u16*)(ws + O_CAQ + l * SZ_CA); j.rows = 512; j.n1 = 512;
  } else if (id < 28) {
    int l = id - 24; j.src = p.ca_w_kv + (size_t)l * 2048 * 1024; j.K = 2048; j.lds = 1024; j.dst = (u16*)(ws + O_CAK + l * SZ_CA); j.rows = 512; j.n1 = 512;
  } else if (id < 32) {
    int l = id - 28; j.src = p.ca_w_kv + (size_t)l * 2048 * 1024; j.K = 2048; j.lds = 1024; j.dst = (u16*)(ws + O_CAV + l * SZ_CA); j.rows = 512; j.n1 = 512; j.off1 = 512;
  } else if (id < 36) {
    int l = id - 32; j.src = p.ca_w_o + (size_t)l * 512 * 2048; j.K = 512; j.lds = 2048; j.dst = (u16*)(ws + O_CAO + l * SZ_CA); j.rows = 2048; j.n1 = 2048;
  } else if (id < 40) {
    int l = id - 36; j.src = p.ffn_w_in + (size_t)l * 2048 * 11264; j.K = 2048; j.lds = 11264; j.dst = (u16*)(ws + O_FFIN + l * SZ_FFIN); j.rows = 11264; j.n1 = 11264; j.ffn = 1;
  } else {
    int l = id - 40; j.src = p.ffn_w_out + (size_t)l * FFH * 2048; j.K = FFH; j.lds = 2048; j.dst = (u16*)(ws + O_FFOUT + l * SZ_FFOUT); j.rows = 2048; j.n1 = 2048;
  }
  return j;
}
constexpr int NJOBS = 44;

DI void convert_phase(const Params& p, char* smem) {
  const int tid5 = TID, half = tid5 >> 8, tid = tid5 & 255;
  constexpr int NU = 3;
  float* tile0 = (float*)smem + half * NU * (64 * 65);
  int* pre = (int*)(smem + 120000);
  if (tid5 < NJOBS) { const CJob j = get_job(p, tid5); pre[64 + tid5] = (j.rows >> 6) * (j.K >> 6); }
  __syncthreads();
  if (tid5 == 0) { int a = 0; for (int i = 0; i < NJOBS; ++i) { pre[i] = a; a += pre[64 + i]; } pre[NJOBS] = a; }
  __syncthreads();
  const int total = pre[NJOBS];
  int jc = 0;
  for (int tb = BID * 2 * NU; tb < total; tb += gridDim.x * 2 * NU) {
    const int rr = tid & 63, kq = tid >> 6;
    float v[NU][16];
    u16* dstp[NU]; int dK[NU];
#pragma unroll
    for (int u = 0; u < NU; ++u) {
      const int tg = tb + half * NU + u; const bool valid = tg < total;
      while (valid && tg >= pre[jc + 1]) ++jc;
      const CJob j = get_job(p, jc);
      const int t = valid ? (tg - pre[jc]) : 0;
      const int kt_n = j.K >> 6;
      const int rt = t / kt_n, kt = t - rt * kt_n;
      const int r = rt * 64 + rr, k0 = kt * 64;
      int c;
      if (j.ffn) { int tt = r >> 8, w = r & 255; c = (w < 128) ? tt * 128 + w : FFH + tt * 128 + (w - 128); }
      else c = (r < j.n1) ? r + j.off1 : ((r < j.n2) ? r + j.off2 : -1);
      const float* sp = j.src + (size_t)(k0 + kq) * j.lds + (c < 0 ? 0 : c);
#pragma unroll
      for (int i = 0; i < 16; ++i) v[u][i] = (valid && c >= 0) ? sp[(size_t)(4 * i) * j.lds] : 0.f;
      dstp[u] = valid ? (j.dst + (size_t)(rt * 64) * j.K + k0) : nullptr; dK[u] = j.K;
    }
#pragma unroll
    for (int u = 0; u < NU; ++u) {
      float* tile = tile0 + u * (64 * 65);
#pragma unroll
      for (int i = 0; i < 16; ++i) tile[(kq + 4 * i) * 65 + rr] = v[u][i];
    }
    __syncthreads();
#pragma unroll
    for (int u = 0; u < NU; ++u) {
      if (dstp[u]) {
        const float* tile = tile0 + u * (64 * 65);
#pragma unroll
        for (int i = 0; i < 2; ++i) {
          const int q = tid + 256 * i, row = q >> 3, ch = q & 7;
          float w[8];
#pragma unroll
          for (int e = 0; e < 8; ++e) w[e] = tile[(ch * 8 + e) * 65 + row];
          u32x4 o; o[0] = pk2(w[0], w[1]); o[1] = pk2(w[2], w[3]); o[2] = pk2(w[4], w[5]); o[3] = pk2(w[6], w[7]);
          *(u32x4*)(dstp[u] + (size_t)row * dK[u] + ch * 8) = o;
        }
      }
    }
    __syncthreads();
  }
  {
    u32x4* zp = (u32x4*)(p.ws + O_STATS); const u32x4 z = {0u, 0u, 0u, 0u};
    const size_t nz = (size_t)12 * 64 * 8 * 256 * 8 / 16;
    for (size_t i = (size_t)BID * NTHR + tid5; i < nz; i += (size_t)gridDim.x * NTHR) zp[i] = z;
  }
  {
    const size_t gtid = (size_t)BID * NTHR + tid5, gstride = (size_t)gridDim.x * NTHR;
    u16* xb = (u16*)(p.ws + O_XB); u16* mb = (u16*)(p.ws + O_MEMB);
    const size_t n1 = (size_t)NTOK * DM / 8, n2 = (size_t)512 * DM / 8;
    for (size_t i0 = gtid; i0 < n1 + n2; i0 += gstride * 4) {
      f32x4 a[4], b[4];
#pragma unroll
      for (int u = 0; u < 4; ++u) {
        const size_t i = i0 + u * gstride;
        if (i < n1 + n2) { const float* sp = (i < n1) ? p.x + i * 8 : p.mem + (i - n1) * 8; a[u] = *(const f32x4*)sp; b[u] = *(const f32x4*)(sp + 4); }
      }
#pragma unroll
      for (int u = 0; u < 4; ++u) {
        const size_t i = i0 + u * gstride;
        if (i < n1 + n2) {
          u16* d = (i < n1) ? xb + i * 8 : mb + (i - n1) * 8;
          u32x4 o; o[0] = pk2(a[u][0], a[u][1]); o[1] = pk2(a[u][2], a[u][3]); o[2] = pk2(b[u][0], b[u][1]); o[3] = pk2(b[u][2], b[u][3]);
          *(u32x4*)d = o;
        }
      }
    }
  }
}

#define XB_TMO      128
#define XB_XCNT(j)  (256  + 64 * (j))
#define XB_XSUB(j)  (1280 + 64 * (j))
#define XB_XGEN(j)  (2304 + 64 * (j))
#define XB_TOP      3328
#define XB_TOPGEN   3392
#define XCD_BAR_WORDS 3456
#define XB_SPIN_CAP (1u << 22)
#define LAS __attribute__((address_space(3)))
DI unsigned xb_ld(unsigned* p)              { return __hip_atomic_load(p, __ATOMIC_RELAXED, __HIP_MEMORY_SCOPE_AGENT); }
DI unsigned xb_add(unsigned* p, unsigned v) { return __hip_atomic_fetch_add(p, v, __ATOMIC_RELAXED, __HIP_MEMORY_SCOPE_AGENT); }
DI unsigned xb_xcc_id() { return (unsigned)__builtin_amdgcn_s_getreg((3 << 11) | 20) & 0xFu; }
#define XB_SPIN(cond, bar) do { unsigned _sp = 0; while (cond) { __builtin_amdgcn_s_sleep(1); \
    if ((++_sp & 255u) == 0u) { if (xb_ld(&(bar)[XB_TMO])) break; if (_sp > XB_SPIN_CAP) { atomicAdd(&(bar)[XB_TMO], 1u); break; } } } } while (0)
struct XcdBarrier { unsigned* bar; unsigned x; volatile LAS unsigned* st; };
DI void xcd_barrier_complete(unsigned* bar, unsigned x, unsigned& nloc, unsigned& nx) {
  const unsigned G = gridDim.x * gridDim.y * gridDim.z;
  unsigned sum, cnt, mine, sp = 0u;
  for (;;) {
    sum = 0u; cnt = 0u; mine = 0u;
#pragma unroll
    for (unsigned j = 0; j < 16; ++j) { const unsigned c = xb_ld(&bar[XB_XCNT(j)]); sum += c; cnt += (c > 0u) ? 1u : 0u; mine = (j == x) ? c : mine; }
    if (sum == G) break;
    __builtin_amdgcn_s_sleep(1);
    if ((++sp & 255u) == 0u) { if (xb_ld(&bar[XB_TMO])) break; if (sp > XB_SPIN_CAP) { atomicAdd(&bar[XB_TMO], 1u); break; } }
  }
  nloc = mine > 0u ? mine : 1u; nx = cnt > 0u ? cnt : 1u;
}
DI void xcd_barrier(const XcdBarrier& b) {
  asm volatile("s_waitcnt vmcnt(0)" ::: "memory");
  __syncthreads();
  if (threadIdx.x == 0) {
    unsigned* bar = b.bar;
    __builtin_amdgcn_s_waitcnt(0);
    unsigned nloc = b.st[0], nx = b.st[1];
    if (nloc == 0u) { xcd_barrier_complete(bar, b.x, nloc, nx); b.st[0] = nloc; b.st[1] = nx; }
    const unsigned old = xb_add(&bar[XB_XSUB(b.x)], 1u);
    const unsigned gen = old / nloc;
    if (old + 1u == (gen + 1u) * nloc) {
      __builtin_amdgcn_fence(__ATOMIC_RELEASE, "agent");
      asm volatile("s_waitcnt vmcnt(0)" ::: "memory");
      const unsigned og = xb_add(&bar[XB_TOP], 1u);
      const unsigned tg = og / nx;
      if (og + 1u == (tg + 1u) * nx) xb_add(&bar[XB_TOPGEN], 1u);
      else XB_SPIN(xb_ld(&bar[XB_TOPGEN]) == tg, bar);
      __builtin_amdgcn_fence(__ATOMIC_ACQUIRE, "agent");
      xb_add(&bar[XB_XGEN(b.x)], 1u);
      asm volatile("s_waitcnt vmcnt(0)" ::: "memory");
    } else {
      XB_SPIN(xb_ld(&bar[XB_XGEN(b.x)]) == gen, bar);
      __builtin_amdgcn_fence(__ATOMIC_ACQUIRE, "agent");
      asm volatile("s_waitcnt vmcnt(0)" ::: "memory");
    }
  }
  __syncthreads();
}

enum { EPI_BF16 = 0, EPI_VT = 1, EPI_RES = 2, EPI_SWIGLU = 3, EPI_LN = 4 };
typedef __attribute__((address_space(1))) unsigned long long gu64;
struct GemmP {
  const u16* A; const u16* B; int lda, ldb, K, Mt, Nt;
  u16* Cb; float* Cf; const float* R; int ldc;
  const float* colscale; float* aux; int aux_n0, aux_cnt; float aux_scale;
  int vt_S; int vt_bstride;
  const float* ln_g; const float* ln_b; float* outf; u16* outb; u64* stats; unsigned* cnt; unsigned* bar;
};
DI GemmP mk_gemm(const u16* A, int lda, const u16* B, int ldb, int K, int Mt, int Nt) {
  GemmP g; g.A = A; g.B = B; g.lda = lda; g.ldb = ldb; g.K = K; g.Mt = Mt; g.Nt = Nt;
  g.Cb = nullptr; g.Cf = nullptr; g.R = nullptr; g.ldc = 0; g.colscale = nullptr; g.aux = nullptr; g.aux_n0 = 1 << 30; g.aux_cnt = 0; g.aux_scale = 1.f;
  g.vt_S = 1; g.vt_bstride = 0;
  g.ln_g = nullptr; g.ln_b = nullptr; g.outf = nullptr; g.outb = nullptr; g.stats = nullptr; g.cnt = nullptr; g.bar = nullptr;
  return g;
}
constexpr int G_HT = 128 * 64;
DI int lds_byte(int r, int c) { const int st = (r >> 4) * 2 + (c >> 5), rr = r & 15, cc = c & 31, ob = rr * 64 + cc * 2; return st * 1024 + (ob ^ (((ob >> 9) & 1) << 5)); }
DI void stage_rc(int b, int& R, int& C) { const int st = b / 1024, sb = b % 1024, swz = sb ^ (((sb >> 9) & 1) << 5); R = (st >> 1) * 16 + swz / 64; C = (st & 1) * 32 + (swz % 64) / 2; }

template <int EPI>
DI void gemm_unit(const GemmP& g, int pm, int pn) {
  u16* shm = (u16*)dynsmem;
#define SA(b, h) (shm + ((b) * 2 + (h)) * G_HT)
#define SB(b, h) (shm + (4 + (b) * 2 + (h)) * G_HT)
#define GLDS(gp, lp) __builtin_amdgcn_global_load_lds((const unsigned*)(gp), (unsigned*)(lp), 16, 0, 0)
#define STAGE_A(P, br, kt) do { const u16* _g = Ab + (long)(br) * lda + (long)(kt) * 64; GLDS(_g + ao0, (char*)(P) + tid * 16); GLDS(_g + ao1, (char*)(P) + tid * 16 + 8192); } while (0)
#define STAGE_B(P, br, kt) do { const u16* _g = Bb + (long)(br) * ldb + (long)(kt) * 64; GLDS(_g + bo0, (char*)(P) + tid * 16); GLDS(_g + bo1, (char*)(P) + tid * 16 + 8192); } while (0)
#define LDA(dst, b, h) _Pragma("unroll") for (int m = 0; m < 4; ++m) _Pragma("unroll") for (int k = 0; k < 2; ++k) \
    dst[m][k] = *reinterpret_cast<const bf16x8*>((char*)SA(b, h) + lds_byte(wr * 64 + m * 16 + fr, k * 32 + fq * 8))
#define LDB(dst, b, h) _Pragma("unroll") for (int n = 0; n < 2; ++n) _Pragma("unroll") for (int k = 0; k < 2; ++k) \
    dst[n][k] = *reinterpret_cast<const bf16x8*>((char*)SB(b, h) + lds_byte(wc * 32 + n * 16 + fr, k * 32 + fq * 8))
#define MMA(ai, bj, At_, Bt_) do { __builtin_amdgcn_s_setprio(1); \
    _Pragma("unroll") for (int m = 0; m < 4; ++m) _Pragma("unroll") for (int n = 0; n < 2; ++n) _Pragma("unroll") for (int k = 0; k < 2; ++k) \
      acc[ai][bj][m][n] = __builtin_amdgcn_mfma_f32_16x16x32_bf16(Bt_[n][k], At_[m][k], acc[ai][bj][m][n], 0, 0, 0); \
    __builtin_amdgcn_s_setprio(0); } while (0)
#define WAIT_V(n) asm volatile("s_waitcnt vmcnt(" #n ")" ::: "memory")
#define WAIT_L(n) asm volatile("s_waitcnt lgkmcnt(" #n ")" ::: "memory")
#define BAR __builtin_amdgcn_s_barrier()
#define SCHED __builtin_amdgcn_sched_barrier(0)
  const int tid = TID;
  const int wid = tid >> 6, lane = tid & 63, wr = wid >> 2, wc = wid & 3, fr = lane & 15, fq = lane >> 4;
  const long lda = g.lda, ldb = g.ldb;
  const u16* Ab = g.A; const u16* Bb = g.B;
  const int brow = pm * 256, bcol = pn * 256;
  int r0_, c0_, r1_, c1_; stage_rc(tid * 16, r0_, c0_); stage_rc(tid * 16 + 8192, r1_, c1_);
  const long ao0 = (long)r0_ * lda + c0_, ao1 = (long)r1_ * lda + c1_, bo0 = (long)r0_ * ldb + c0_, bo1 = (long)r1_ * ldb + c1_;
  f32x4 acc[2][2][4][2];
#pragma unroll
  for (int a = 0; a < 2; ++a)
#pragma unroll
    for (int b = 0; b < 2; ++b)
#pragma unroll
      for (int m = 0; m < 4; ++m)
#pragma unroll
        for (int n = 0; n < 2; ++n) acc[a][b][m][n] = (f32x4){0.f, 0.f, 0.f, 0.f};
  bf16x8 At[4][2], B0[2][2], B1[2][2];
  const int nt = g.K >> 6;
  STAGE_B(SB(0, 0), bcol, 0); STAGE_A(SA(0, 0), brow, 0);
  STAGE_B(SB(0, 1), bcol + 128, 0); STAGE_A(SA(0, 1), brow + 128, 0);
  if (wr == 1) BAR;
  WAIT_V(4); BAR;
  STAGE_B(SB(1, 0), bcol, 1); STAGE_A(SA(1, 0), brow, 1); STAGE_B(SB(1, 1), bcol + 128, 1);
  WAIT_V(6); BAR;
#pragma unroll 1
  for (int t = 0; t < nt - 2; t += 2) {
    LDB(B0, 0, 0); SCHED; LDA(At, 0, 0); STAGE_A(SA(1, 1), brow + 128, t + 1);
    WAIT_L(8); BAR; WAIT_L(0); MMA(0, 0, At, B0); BAR; SCHED;
    LDB(B1, 0, 1); STAGE_B(SB(0, 0), bcol, t + 2);
    BAR; WAIT_L(0); MMA(0, 1, At, B1); BAR;
    LDA(At, 0, 1); STAGE_A(SA(0, 0), brow, t + 2);
    BAR; WAIT_L(0); MMA(1, 0, At, B0); BAR; SCHED;
    STAGE_B(SB(0, 1), bcol + 128, t + 2);
    WAIT_V(6); BAR; MMA(1, 1, At, B1); BAR;
    LDB(B0, 1, 0); SCHED; LDA(At, 1, 0); STAGE_A(SA(0, 1), brow + 128, t + 2);
    WAIT_L(8); BAR; WAIT_L(0); MMA(0, 0, At, B0); BAR; SCHED;
    LDB(B1, 1, 1); STAGE_B(SB(1, 0), bcol, t + 3);
    BAR; WAIT_L(0); MMA(0, 1, At, B1); BAR;
    LDA(At, 1, 1); STAGE_A(SA(1, 0), brow, t + 3);
    BAR; WAIT_L(0); MMA(1, 0, At, B0); BAR; SCHED;
    STAGE_B(SB(1, 1), bcol + 128, t + 3);
    WAIT_V(6); BAR; MMA(1, 1, At, B1); BAR;
  }
  { LDB(B0, 0, 0); LDA(At, 0, 0); STAGE_A(SA(1, 1), brow + 128, nt - 1);
    BAR; WAIT_L(0); MMA(0, 0, At, B0); BAR;
    LDB(B1, 0, 1); BAR; WAIT_L(0); MMA(0, 1, At, B1); BAR;
    LDA(At, 0, 1); WAIT_V(4); BAR; WAIT_L(0); MMA(1, 0, At, B0); MMA(1, 1, At, B1); BAR; }
  { LDB(B0, 1, 0); LDA(At, 1, 0); WAIT_V(2); BAR; WAIT_L(0); MMA(0, 0, At, B0); BAR;
    LDB(B1, 1, 1); WAIT_V(0); BAR; WAIT_L(0); MMA(0, 1, At, B1); BAR;
    LDA(At, 1, 1); BAR; WAIT_L(0); MMA(1, 0, At, B0); MMA(1, 1, At, B1); BAR; }
  if (wr == 0) BAR;
  const int row0 = brow + wr * 64 + fr, colb = bcol + wc * 32 + fq * 4;
  if (EPI == EPI_LN) {
    float* red = (float*)dynsmem;
    float* mr = (float*)dynsmem + 2048;
#pragma unroll
    for (int ai = 0; ai < 2; ++ai)
#pragma unroll
      for (int m = 0; m < 4; ++m) {
        const int row = row0 + ai * 128 + m * 16;
        float s1 = 0.f, s2 = 0.f;
#pragma unroll
        for (int bj = 0; bj < 2; ++bj)
#pragma unroll
          for (int n = 0; n < 2; ++n) {
            const size_t idx = (size_t)row * 2048 + colb + bj * 128 + n * 16;
            f32x4 rv;
            if (g.R) rv = *(const f32x4*)(g.R + idx);
            else { const uint2 rb = *(const uint2*)(g.outb + idx); rv[0] = bflo(rb.x); rv[1] = bfhi(rb.x); rv[2] = bflo(rb.y); rv[3] = bfhi(rb.y); }
            const f32x4 y = rv * ALPHA_ + acc[ai][bj][m][n];
            acc[ai][bj][m][n] = y;
            s1 += (y[0] + y[1]) + (y[2] + y[3]);
            s2 += (y[0] * y[0] + y[1] * y[1]) + (y[2] * y[2] + y[3] * y[3]);
          }
        s1 += shflx(s1, 16, lane); s2 += shflx(s2, 16, lane);
        s1 += shflx(s1, 32, lane); s2 += shflx(s2, 32, lane);
        if (fq == 0) { const int rl = ai * 128 + wr * 64 + m * 16 + fr; red[(rl * 4 + wc) * 2] = s1; red[(rl * 4 + wc) * 2 + 1] = s2; }
      }
    __syncthreads();
    gu64* st = (gu64*)g.stats + (size_t)pm * 8 * 256;
    if (tid < 256) {
      float a = 0.f, b = 0.f;
#pragma unroll
      for (int w = 0; w < 4; ++w) { a += red[(tid * 4 + w) * 2]; b += red[(tid * 4 + w) * 2 + 1]; }
      const u64 pk = ((u64)(__float_as_uint(b) | 0x80000000u) << 32) | (u64)__float_as_uint(a);
      __hip_atomic_store(st + pn * 256 + tid, pk, __ATOMIC_RELAXED, __HIP_MEMORY_SCOPE_AGENT);
      float sa = 0.f, sb = 0.f;
#pragma unroll 1
      for (int k = 0; k < 8; ++k) {
        u64 v = 0; unsigned sp = 0;
        for (;;) {
          v = __hip_atomic_load(st + k * 256 + tid, __ATOMIC_RELAXED, __HIP_MEMORY_SCOPE_AGENT);
          if (v >> 63) break;
          __builtin_amdgcn_s_sleep(1);
          if (++sp > XB_SPIN_CAP) break;
        }
        sa += __uint_as_float((unsigned)v); sb += __uint_as_float((unsigned)(v >> 32) & 0x7fffffffu);
      }
      const float mean = sa * (1.f / 2048.f);
      const float var = fmaxf(sb * (1.f / 2048.f) - mean * mean, 0.f);
      mr[tid * 2] = mean; mr[tid * 2 + 1] = rsqrtf(var + 1e-5f);
    }
    __syncthreads();
#pragma unroll
    for (int ai = 0; ai < 2; ++ai)
#pragma unroll
      for (int m = 0; m < 4; ++m) {
        const int rl = ai * 128 + wr * 64 + m * 16 + fr;
        const float mean = mr[rl * 2], rs = mr[rl * 2 + 1];
        const int row = row0 + ai * 128 + m * 16;
#pragma unroll
        for (int bj = 0; bj < 2; ++bj)
#pragma unroll
          for (int n = 0; n < 2; ++n) {
            const int col = colb + bj * 128 + n * 16;
            const f32x4 gg = *(const f32x4*)(g.ln_g + col), bb = *(const f32x4*)(g.ln_b + col);
            const f32x4 o = (acc[ai][bj][m][n] - mean) * rs * gg + bb;
            const size_t idx = (size_t)row * 2048 + col;
            if (g.outf) *(f32x4*)(g.outf + idx) = o;
            uint2 ob; ob.x = pk2(o[0], o[1]); ob.y = pk2(o[2], o[3]);
            *(uint2*)(g.outb + idx) = ob;
          }
      }
    __syncthreads();
  } else if (EPI == EPI_SWIGLU) {
    const int hc0 = pn * 128 + wc * 32 + fq * 4;
#pragma unroll
    for (int ai = 0; ai < 2; ++ai)
#pragma unroll
      for (int m = 0; m < 4; ++m) {
        u16* rowp = g.Cb + (size_t)(row0 + ai * 128 + m * 16) * g.ldc + hc0;
#pragma unroll
        for (int n = 0; n < 2; ++n) {
          const f32x4 gv = acc[ai][0][m][n], uv = acc[ai][1][m][n];
          float hv[4];
#pragma unroll
          for (int e = 0; e < 4; ++e) hv[e] = gv[e] * __builtin_amdgcn_rcpf(1.f + __builtin_amdgcn_exp2f(-LOG2E * gv[e])) * uv[e];
          uint2 o; o.x = pk2(hv[0], hv[1]); o.y = pk2(hv[2], hv[3]);
          *(uint2*)(rowp + n * 16) = o;
        }
      }
  } else {
#pragma unroll
    for (int ai = 0; ai < 2; ++ai)
#pragma unroll
      for (int m = 0; m < 4; ++m) {
        const int row = row0 + ai * 128 + m * 16;
#pragma unroll
        for (int bj = 0; bj < 2; ++bj)
#pragma unroll
          for (int n = 0; n < 2; ++n) {
            const int col = colb + bj * 128 + n * 16;
            f32x4 v = acc[ai][bj][m][n];
            if (EPI == EPI_BF16) {
              if (col >= g.aux_n0) {
                const int c2 = col - g.aux_n0;
                if (c2 < g.aux_cnt) *(f32x4*)(g.aux + (size_t)row * 16 + c2) = v * g.aux_scale;
              } else {
                if (g.colscale) v = v * *(const f32x4*)(g.colscale + col);
                uint2 o; o.x = pk2(v[0], v[1]); o.y = pk2(v[2], v[3]);
                *(uint2*)(g.Cb + (size_t)row * g.ldc + col) = o;
              }
            } else if (EPI == EPI_VT) {
              const int b = col / g.vt_S, sx = col - b * g.vt_S;
              uint2 o; o.x = pk2(v[0], v[1]); o.y = pk2(v[2], v[3]);
              *(uint2*)(g.Cb + (size_t)b * g.vt_bstride + (size_t)row * g.ldc + sx) = o;
            } else {
              const size_t idx = (size_t)row * g.ldc + col;
              const f32x4 rv = *(const f32x4*)(g.R + idx);
              *(f32x4*)(g.Cf + idx) = rv * ALPHA_ + v;
            }
          }
      }
  }
#undef SA
#undef SB
#undef GLDS
#undef STAGE_A
#undef STAGE_B
#undef LDA
#undef LDB
#undef MMA
}

DI bool unit_of(int L, int nM, int nN, int& pm, int& pn) {
  const int nwg = nM * nN; if (L >= nwg) return false;
  int wgid = L; { const int q = nwg / 8, r = nwg % 8, xcd = wgid % 8, off = wgid / 8; wgid = (xcd < r ? xcd * (q + 1) : r * (q + 1) + (xcd - r) * q) + off; }
  const int nig = 8 * nN, gid = wgid / nig, fm = gid * 8, gsz = (nM - fm) < 8 ? (nM - fm) : 8;
  pm = fm + ((wgid % nig) % gsz); pn = (wgid % nig) / gsz; return true;
}
DI void gemm_phase_ln(const GemmP& g) {
  const int c = BID;
  for (int r = 0; r < 2; ++r) gemm_unit<EPI_LN>(g, 32 * r + (c & 31), c >> 5);
}
template <int E1, int E2>
DI void gemm_phase2(const GemmP& g1, const GemmP& g2, char* smem) {
  const int n1 = g1.Mt * g1.Nt, n2 = g2.Mt * g2.Nt;
  for (int L = BID; L < n1 + n2; L += gridDim.x) {
    int pm, pn;
    if (L < n1) { unit_of(L, g1.Mt, g1.Nt, pm, pn); gemm_unit<E1>(g1, pm, pn); }
    else { unit_of(L - n1, g2.Mt, g2.Nt, pm, pn); gemm_unit<E2>(g2, pm, pn); }
  }
}

template <int MODE>
DI void attn_item(const u16* Qp, int ldq, const u16* Kp, int ldk, const u16* VTp, int ldv, u16* Op, int ldo,
                  int q0, int nkt, const float* Fc, const unsigned* BM, float kmaxn, char* smem) {
  const int tid = TID, lane = tid & 63, wave = tid >> 6;
  const int r = lane & 31, h = lane >> 5;
  const int qw = q0 + wave * 32, q = qw + r;
  const float c1 = 0.08838834764831845f * LOG2E;
  bf16x8 qf[8];
#pragma unroll
  for (int st = 0; st < 8; ++st) qf[st] = *(const bf16x8*)(Qp + (size_t)q * ldq + st * 16 + h * 8);
  f32x16 o[4];
#pragma unroll
  for (int i = 0; i < 4; ++i)
#pragma unroll
    for (int e = 0; e < 16; ++e) o[i][e] = 0.f;
  float m_run = -1e30f, l_run = 0.f;
  float fcq = 0.f;
  if (MODE == 1) fcq = Fc[q];
  const int krow = tid >> 4, kch = (tid & 15) ^ (krow & 15);
  const int vrow = tid >> 3, vch = (tid & 7) ^ ((tid >> 4) & 7);
  const u16* Kg0 = Kp + (size_t)krow * ldk + kch * 8; const size_t k32 = (size_t)32 * ldk;
  const u16* Vg0 = VTp + (size_t)vrow * ldv + vch * 8; const size_t v64 = (size_t)64 * ldv;
  const int pr = (r & 0x13) | ((r & 4) << 1) | ((r & 8) >> 1);
  const unsigned kro = pr * 256; const int ksw = pr & 15;
  const unsigned vro = r * 128; const int vsw = (r >> 1) & 7;
  float* fct = (float*)(smem + 131072 + 64);
  const unsigned* bmq = BM + (size_t)q * 256;
#define AT_GLDS(gp, lp) __builtin_amdgcn_global_load_lds((const unsigned*)(gp), (unsigned*)(lp), 16, 0, 0)
#define AT_TILE(it) ((MODE == 1) ? (nkt - 1 - (it)) : (it))
#define AT_STAGE(tile) do { const int _i = (tile) < nkt ? (tile) : (nkt - 1); const int _t = AT_TILE(_i); char* _s = dynsmem + ((tile) & 3) * 32768 + tid * 16; \
    const u16* _kg = Kg0 + (size_t)_t * 64 * ldk; const u16* _vg = Vg0 + _t * 64; \
    AT_GLDS(_kg, _s); AT_GLDS(_kg + k32, _s + 8192); AT_GLDS(_vg, _s + 16384); AT_GLDS(_vg + v64, _s + 16384 + 8192); } while (0)
  f32x4 rf = {0.f, 0.f, 0.f, 0.f};
  uint2 bw = make_uint2(0xffffffffu, 0xffffffffu);
  if (MODE == 1) rf = *(const f32x4*)(Fc + AT_TILE(0) * 64 + (tid & 15) * 4);
  if (MODE == 2) bw = *(const uint2*)(bmq);
  float qkb = 0.f;
  if (MODE == 1) {
    float qs = 0.f;
#pragma unroll
    for (int st = 0; st < 8; ++st)
#pragma unroll
      for (int e = 0; e < 8; ++e) { const float v = bf2f((u16)qf[st][e]); qs += v * v; }
    qs += shflx(qs, 32, lane);
    qkb = sqrtf(qs) * kmaxn * c1 * 1.01f + fcq;
  }
  int* votes = (int*)(smem + 131072 + 64 + 1024);
  AT_STAGE(0); AT_STAGE(1); AT_STAGE(2);
  if (MODE == 1 && tid < 16) *(f32x4*)(fct + tid * 4) = rf;
  asm volatile("s_waitcnt vmcnt(0)" ::: "memory");
  __syncthreads();
  f32x16 sc[2];
#pragma unroll
  for (int k2 = 0; k2 < 2; ++k2) {
#pragma unroll
    for (int e = 0; e < 16; ++e) sc[k2][e] = 0.f;
#pragma unroll
    for (int st = 0; st < 8; ++st) {
      bf16x8 a = *(const bf16x8*)(smem + kro + k2 * 8192 + (((st * 2 + h) ^ ksw) << 4));
      sc[k2] = MFMA(a, qf[st], sc[k2]);
    }
  }
#pragma unroll 1
  for (int kt = 0; kt < nkt; ++kt) {
    const char* sKn = smem + ((kt + 1) & 3) * 32768;
    const char* sV = smem + (kt & 3) * 32768 + 16384;
    const float* sF = fct + (kt & 3) * 64;
    const int ts = AT_TILE(kt) * 64;
    const bool more1 = (kt + 1 < nkt);
    uint2 bwn = make_uint2(0xffffffffu, 0xffffffffu);
    const int tn = AT_TILE(more1 ? (kt + 1) : kt);
    float flast = 0.f;
    if (MODE == 1) { rf = *(const f32x4*)(Fc + tn * 64 + (tid & 15) * 4); flast = Fc[tn * 64 + 63]; }
    if (MODE == 2) bwn = *(const uint2*)(bmq + tn * 2);
    AT_STAGE(kt + 3);
    const bool diag = (MODE == 1) && (ts + 63 > qw);
    float mx = -1e30f;
    if (MODE == 1) {
#pragma unroll
      for (int k2 = 0; k2 < 2; ++k2)
#pragma unroll
        for (int j = 0; j < 4; ++j) {
          const int kl = 32 * k2 + 16 * (j >> 1) + 8 * h + 4 * (j & 1);
          const f32x4 f4 = *(const f32x4*)(sF + kl);
#pragma unroll
          for (int i = 0; i < 4; ++i) {
            float x = sc[k2][j * 4 + i] * c1 + (fcq - f4[i]);
            if (diag && (ts + kl + i > q)) x = -1e30f;
            sc[k2][j * 4 + i] = x;
            mx = fmaxf(mx, x);
          }
        }
    } else {
#pragma unroll
      for (int k2 = 0; k2 < 2; ++k2)
#pragma unroll
        for (int e = 0; e < 16; ++e) mx = fmaxf(mx, sc[k2][e]);
      mx *= c1;
    }
    mx = fmaxf(mx, shflx(mx, 32, lane));
    if (__any(mx > m_run + 8.f)) {
      const float m_new = fmaxf(m_run, mx);
      const float alpha = __builtin_amdgcn_exp2f(m_run - m_new);
      m_run = m_new; l_run *= alpha;
#pragma unroll
      for (int i = 0; i < 4; ++i)
#pragma unroll
        for (int e = 0; e < 16; ++e) o[i][e] *= alpha;
    }
    f32x16 sn[2];
    float ps = 0.f;
#pragma unroll
    for (int g4 = 0; g4 < 4; ++g4) {
      const int k2 = g4 >> 1, s2 = g4 & 1;
      const f32x16 zero16 = {0.f, 0.f, 0.f, 0.f, 0.f, 0.f, 0.f, 0.f, 0.f, 0.f, 0.f, 0.f, 0.f, 0.f, 0.f, 0.f};
#pragma unroll
      for (int st = s2 * 4; st < s2 * 4 + 4; ++st) {
        bf16x8 a = *(const bf16x8*)(sKn + kro + k2 * 8192 + (((st * 2 + h) ^ ksw) << 4));
        sn[k2] = (st == 0) ? MFMA(a, qf[st], zero16) : MFMA(a, qf[st], sn[k2]);
      }
      const unsigned wbits = k2 ? bw.y : bw.x;
      float pv8[8];
#pragma unroll
      for (int e8 = 0; e8 < 8; ++e8) {
        const int e = 8 * s2 + e8;
        float pv;
        if (MODE == 1) {
          const float x = sc[k2][e];
          pv = __builtin_amdgcn_exp2f(x - m_run);
          if (diag) pv = (x <= -1e29f) ? 0.f : pv;
        } else {
          pv = __builtin_amdgcn_exp2f(sc[k2][e] * c1 - m_run);
          if (MODE == 2) {
            const int kb = 16 * ((e >> 2) >> 1) + 8 * h + 4 * ((e >> 2) & 1) + (e & 3);
            const int msk = __builtin_amdgcn_sbfe(wbits, kb, 1);
            pv = __int_as_float(__float_as_int(pv) & msk);
          }
        }
        pv8[e8] = pv; ps += pv;
      }
      u32x4 u;
      u[0] = pk2(pv8[0], pv8[1]); u[1] = pk2(pv8[2], pv8[3]); u[2] = pk2(pv8[4], pv8[5]); u[3] = pk2(pv8[6], pv8[7]);
      const bf16x8 pfg = __builtin_bit_cast(bf16x8, u);
#pragma unroll
      for (int dt = 0; dt < 4; ++dt) {
        bf16x8 a = *(const bf16x8*)(sV + vro + dt * 4096 + (((4 * k2 + 2 * s2 + h) ^ vsw) << 4));
        o[dt] = MFMA(a, pfg, o[dt]);
      }
      __builtin_amdgcn_sched_barrier(0);
    }
    l_run += ps;
    asm volatile("s_waitcnt vmcnt(4)" ::: "memory");
    if (MODE == 1 && tid < 16) *(f32x4*)(fct + ((kt + 1) & 3) * 64 + tid * 4) = rf;
    if (MODE == 1) {
      const int v = __all((qkb - flast) < (m_run - 160.f)) ? 1 : 0;
      if (lane == 0) votes[(kt & 1) * 8 + wave] = v;
    }
    asm volatile("s_waitcnt lgkmcnt(0)" ::: "memory");
    __builtin_amdgcn_s_barrier();
    asm volatile("" ::: "memory");
    sc[0] = sn[0]; sc[1] = sn[1]; bw = bwn;
    if (MODE == 1) {
      const int* vp = votes + (kt & 1) * 8;
      const int all8 = vp[0] & vp[1] & vp[2] & vp[3] & vp[4] & vp[5] & vp[6] & vp[7];
      if (all8) break;
    }
  }
  asm volatile("s_waitcnt vmcnt(0)" ::: "memory");
  __syncthreads();
#undef AT_STAGE
#undef AT_TILE
#undef AT_GLDS
  const float l = l_run + shflx(l_run, 32, lane);
  const float inv = 1.f / l;
  u16* orow = Op + (size_t)q * ldo;
#pragma unroll
  for (int dt = 0; dt < 4; ++dt)
#pragma unroll
    for (int j = 0; j < 4; ++j) {
      uint2 u; u.x = pk2(o[dt][j * 4 + 0] * inv, o[dt][j * 4 + 1] * inv); u.y = pk2(o[dt][j * 4 + 2] * inv, o[dt][j * 4 + 3] * inv);
      *(uint2*)(orow + 32 * dt + 8 * j + 4 * h) = u;
    }
}

template <int MODE>
DI void self_attn_phase(const Params& p, int qcol, int kcol, int j, char* smem) {
  const u16* H = (const u16*)(p.ws + O_H); const u16* VT = (const u16*)(p.ws + O_VT); u16* CAT = (u16*)(p.ws + O_CAT);
  const float* FC = (const float*)(p.ws + O_FC); const unsigned* BM = (const unsigned*)(p.ws + O_BM);
  for (int idx = BID; idx < 512; idx += gridDim.x) {
    const int bh = idx & 15, qi = idx >> 4;
    const int qb = (qi < 16) ? (31 - qi) : (qi - 16);
    const int b = bh >> 3, hd = bh & 7;
    const int q0 = qb * 256, nkt = 4 * (qb + 1);
    attn_item<MODE>(H + (size_t)b * S_ * HLD + qcol + hd * 128, HLD, H + (size_t)b * S_ * HLD + kcol + hd * 128, HLD,
                    VT + ((size_t)b * 1024 + hd * 128) * S_, S_, CAT + (size_t)b * S_ * DM + 1024 + hd * 128, DM,
                    q0, nkt, FC + (size_t)(b * 8 + hd) * S_, BM + (size_t)b * S_ * 256,
                    (MODE == 1) ? sqrtf(__uint_as_float(((const unsigned*)(p.ws + O_BAR))[KN_WORD0 + j * 8 + hd])) : 0.f, smem);
  }
}
DI void cross_attn_phase(const Params& p, int layer, char* smem) {
  const u16* CQ = (const u16*)(p.ws + O_CQ); u16* CO = (u16*)(p.ws + O_CO);
  const u16* MK = (const u16*)(p.ws + O_MEMK) + (size_t)layer * 512 * 512;
  const u16* MVT = (const u16*)(p.ws + O_MEMVT) + (size_t)layer * 512 * 512;
  for (int idx = BID; idx < 256; idx += gridDim.x) {
    const int bh = idx & 7, qb = idx >> 3, b = bh >> 2, hd = bh & 3;
    attn_item<0>(CQ + (size_t)b * S_ * 512 + hd * 128, 512, MK + (size_t)b * 256 * 512 + hd * 128, 512,
                 MVT + ((size_t)b * 512 + hd * 128) * 256, 256, CO + (size_t)b * S_ * 512 + hd * 128, 512,
                 qb * 256, 4, nullptr, nullptr, 0.f, smem);
  }
}

DI void score_phase(const Params& p, char* smem) {
  const u16* H = (const u16*)(p.ws + O_H); const float* AUX = (const float*)(p.ws + O_AUX); float* SC = (float*)(p.ws + O_SC);
  const int tid = TID, lane = tid & 63, wave = tid >> 6, r = lane & 31, h = lane >> 5;
  float* wl = (float*)smem + wave * 128;
  for (int idx = BID; idx < 512; idx += gridDim.x) {
    const int half = idx & 1, b = (idx >> 1) & 1, t = idx >> 2;
    const int blk = (t < 64) ? (127 - t) : (t - 64);
    const int n = (blk + 1) * 64, ntile = n >> 5;
    const int nt_lo = half ? (ntile >> 1) : 0, nt_hi = half ? ntile : (ntile >> 1);
    const int t0 = blk * 64 + wave * 8;
    const u16* Hb = H + (size_t)b * S_ * HLD;
    bf16x8 af[4][4];
#pragma unroll
    for (int rt = 0; rt < 4; ++rt) {
      const int tokA = t0 + 2 * rt + ((r >> 2) & 1), head = (r >> 3) * 4 + (r & 3);
#pragma unroll
      for (int st = 0; st < 4; ++st) af[rt][st] = *(const bf16x8*)(Hb + (size_t)tokA * HLD + 3072 + head * 64 + st * 16 + 8 * h);
    }
    wl[lane] = AUX[(size_t)(b * S_ + t0) * 16 + lane] * 0.125f;
    wl[64 + lane] = AUX[(size_t)(b * S_ + t0) * 16 + 64 + lane] * 0.125f;
    __syncthreads();
    float* scb = SC + (size_t)b * SCB + (size_t)2048 * blk * (blk + 1);
    bf16x8 bfr[4], bnx[4];
#pragma unroll
    for (int st = 0; st < 4; ++st) bfr[st] = *(const bf16x8*)(Hb + (size_t)(nt_lo * 32 + r) * HLD + 4096 + st * 16 + 8 * h);
#pragma unroll 1
    for (int nt2 = nt_lo; nt2 < nt_hi; ++nt2) {
      const int k0 = nt2 * 32;
      const int kn = (nt2 + 1 < nt_hi) ? (k0 + 32) : k0;
#pragma unroll
      for (int st = 0; st < 4; ++st) bnx[st] = *(const bf16x8*)(Hb + (size_t)(kn + r) * HLD + 4096 + st * 16 + 8 * h);
#pragma unroll
      for (int rt = 0; rt < 4; ++rt) {
        f32x16 acc;
#pragma unroll
        for (int e = 0; e < 16; ++e) acc[e] = 0.f;
#pragma unroll
        for (int st = 0; st < 4; ++st) acc = MFMA(af[rt][st], bfr[st], acc);
        float s = 0.f;
#pragma unroll
        for (int e4 = 0; e4 < 4; ++e4) {
          const f32x4 wv = *(const f32x4*)(wl + (2 * rt + h) * 16 + e4 * 4);
#pragma unroll
          for (int i = 0; i < 4; ++i) s += fmaxf(acc[e4 * 4 + i], 0.f) * wv[i];
        }
        const int row = (t0 + 2 * rt + h) - blk * 64;
        scb[(size_t)row * n + k0 + r] = s;
      }
#pragma unroll
      for (int st = 0; st < 4; ++st) bfr[st] = bnx[st];
    }
    __syncthreads();
  }
}

DI int wave_sum_i(int v, int lane) {
#pragma unroll
  for (int o = 32; o > 0; o >>= 1) v += shflxi(v, o, lane);
  return v;
}
template <int NJ>
DI void select_row(const float* row, int n, u64* bmrow, int lane) {
  unsigned key[NJ];
#pragma unroll
  for (int jj = 0; jj < NJ; ++jj) {
    const int idx = jj * 64 + lane;
    unsigned k = 0;
    if (idx < n) { unsigned u = __float_as_uint(row[idx]); k = (u & 0x80000000u) ? ~u : (u | 0x80000000u); }
    key[jj] = k;
  }
  unsigned km = 0;
#pragma unroll
  for (int jj = 0; jj < NJ; ++jj) km = (key[jj] > km) ? key[jj] : km;
#pragma unroll
  for (int o = 32; o > 0; o >>= 1) { const unsigned t = (unsigned)shflxi((int)km, o, lane); km = (t > km) ? t : km; }
  unsigned lo = 0, hi = (km == 0xffffffffu) ? km : (km + 1u), T = 0;
  bool exact = false;
  {
    unsigned cand = km & 0xff800000u;
#pragma unroll 1
    for (int pr = 0; pr < 4; ++pr) {
      if (cand <= lo || cand >= hi) break;
      int c = 0;
#pragma unroll
      for (int jj = 0; jj < NJ; ++jj)
        asm volatile("v_cmp_le_u32 vcc, %1, %2\n\tv_addc_co_u32 %0, vcc, 0, %0, vcc" : "+v"(c) : "s"(cand), "v"(key[jj]) : "vcc");
      c = wave_sum_i(c, lane);
      if (c == 256) { T = cand; exact = true; break; }
      if (c > 256) { lo = cand; break; }
      hi = cand;
      if (cand < 0x00800000u) break;
      cand -= 0x00800000u;
    }
  }
#pragma unroll 1
  while (!exact && hi - lo > 1u) {
    const unsigned cand = lo + ((hi - lo) >> 1);
    int c = 0;
#pragma unroll
    for (int jj = 0; jj < NJ; ++jj)
      asm volatile("v_cmp_le_u32 vcc, %1, %2\n\tv_addc_co_u32 %0, vcc, 0, %0, vcc" : "+v"(c) : "s"(cand), "v"(key[jj]) : "vcc");
    c = wave_sum_i(c, lane);
    if (c == 256) { T = cand; exact = true; }
    else if (c > 256) lo = cand; else hi = cand;
  }
  if (!exact) T = lo;
  unsigned X = 0xffffffffu;
  if (!exact) {
    int cgt = 0, ceq = 0;
#pragma unroll
    for (int jj = 0; jj < NJ; ++jj) {
      asm volatile("v_cmp_lt_u32 vcc, %1, %2\n\tv_addc_co_u32 %0, vcc, 0, %0, vcc" : "+v"(cgt) : "s"(T), "v"(key[jj]) : "vcc");
      asm volatile("v_cmp_eq_u32 vcc, %1, %2\n\tv_addc_co_u32 %0, vcc, 0, %0, vcc" : "+v"(ceq) : "s"(T), "v"(key[jj]) : "vcc");
    }
    cgt = wave_sum_i(cgt, lane); ceq = wave_sum_i(ceq, lane);
    const int need = 256 - cgt;
    unsigned bigv = 0x7fffffffu;
    asm volatile("" : "+v"(bigv));
    if (ceq != need) {
      X = 0;
#pragma unroll 1
      for (int bit = 13; bit >= 0; --bit) {
        const unsigned cand = X | (1u << bit);
        int c = 0;
#pragma unroll
        for (int jj = 0; jj < NJ; ++jj) {
          unsigned tmp;
          asm volatile("v_add_u32 %1, %7, %5\n\tv_cmp_eq_u32 vcc, %2, %3\n\tv_cndmask_b32 %1, %4, %1, vcc\n\tv_cmp_gt_u32 vcc, %6, %1\n\tv_addc_co_u32 %0, vcc, 0, %0, vcc"
                       : "+v"(c), "=&v"(tmp) : "s"(T), "v"(key[jj]), "v"(bigv), "v"(lane), "s"(cand), "n"(jj * 64) : "vcc");
        }
        c = wave_sum_i(c, lane);
        if (c <= need) X = cand;
      }
    }
  }
  unsigned kl0 = 0, kh0 = 0, kl1 = 0, kh1 = 0;
  unsigned T1v = T + 1, Tv = T;
  asm volatile("" : "+v"(Tv), "+v"(T1v));
#pragma unroll
  for (int jj = 0; jj < NJ; ++jj) {
    unsigned tmp;
    if (jj < 64)
      asm volatile("v_add_u32 %2, %9, %4\n\tv_cmp_gt_u32 vcc, %3, %2\n\tv_cndmask_b32 %2, %5, %6, vcc\n\tv_cmp_ge_u32 vcc, %7, %2\n\ts_nop 3\n\tv_writelane_b32 %0, vcc_lo, %8\n\tv_writelane_b32 %1, vcc_hi, %8"
                   : "+v"(kl0), "+v"(kh0), "=&v"(tmp) : "s"(X), "v"(lane), "v"(T1v), "v"(Tv), "v"(key[jj]), "n"(jj & 63), "n"(jj * 64) : "vcc");
    else
      asm volatile("v_add_u32 %2, %9, %4\n\tv_cmp_gt_u32 vcc, %3, %2\n\tv_cndmask_b32 %2, %5, %6, vcc\n\tv_cmp_ge_u32 vcc, %7, %2\n\ts_nop 3\n\tv_writelane_b32 %0, vcc_lo, %8\n\tv_writelane_b32 %1, vcc_hi, %8"
                   : "+v"(kl1), "+v"(kh1), "=&v"(tmp) : "s"(X), "v"(lane), "v"(T1v), "v"(Tv), "v"(key[jj]), "n"(jj & 63), "n"(jj * 64) : "vcc");
  }
  bmrow[lane] = ((u64)kh0 << 32) | kl0; bmrow[64 + lane] = ((u64)kh1 << 32) | kl1;
}
DI void select_phase(const Params& p) {
  const float* SC = (const float*)(p.ws + O_SC); u64* BM = (u64*)(p.ws + O_BM);
  const int tid_ = TID; const int lane = tid_ & 63, wave = tid_ >> 6;
  const int nw = gridDim.x * NWAVE, gw = BID * NWAVE + wave;
  int it = 0;
  for (int base = 0; base < NTOK; base += nw, ++it) {
    const int rowi = base + ((it & 1) ? (nw - 1 - gw) : gw);
    if (rowi >= NTOK) continue;
    const int b = rowi >> 13, t = rowi & 8191, blk = t >> 6, rr = t & 63, n = (blk + 1) * 64;
    const float* row = SC + (size_t)b * SCB + (size_t)2048 * blk * (blk + 1) + (size_t)rr * n;
    u64* bmrow = BM + (size_t)rowi * 128;
    if (n <= 256) {
      const int nwd = n >> 6;
      bmrow[lane] = (lane < nwd) ? ~0ull : 0ull; bmrow[64 + lane] = 0ull;
    } else if (n <= 2048) select_row<32>(row, n, bmrow, lane);
    else if (n <= 4096) select_row<64>(row, n, bmrow, lane);
    else select_row<128>(row, n, bmrow, lane);
  }
}

DI void prep_even(const Params& p, int j, char* smem) {
  u16* H = (u16*)(p.ws + O_H); u16* DP = (u16*)(p.ws + O_DP);
  const int tid5 = TID, tid = tid5 & 255;
  const int gs = gridDim.x * 2;
  constexpr int NB = 4;
  const int which = tid >> 7, tt = tid & 127;
  const int offA = 1024 + which * 1024 + (tt >> 4) * 128 + (tt & 15);
  const int fiA = tt & 15;
  const bool hasB = tid < 136;
  const int offB = (tid < 128) ? (3072 + (tid >> 3) * 64 + (tid & 7)) : (4096 + (tid - 128));
  const int fiB = 16 + ((tid < 128) ? (tid & 7) : ((tid - 128) & 7));
  const int c0 = tid * 4, g = c0 >> 8, w = 2 << g;
  for (int tok0 = BID * 2 + (tid5 >> 8); tok0 < NTOK; tok0 += gs * NB) {
    float pos[NB], a1[NB], a2[NB], b1[NB], b2[NB];
#pragma unroll
    for (int u = 0; u < NB; ++u) {
      const int tok = tok0 + u * gs; const bool ok = tok < NTOK;
      const u16* hr = H + (size_t)(ok ? tok : 0) * HLD;
      pos[u] = (float)p.pos[ok ? tok : 0];
      a1[u] = bf2f(hr[offA]); a2[u] = bf2f(hr[offA + 16]);
      b1[u] = hasB ? bf2f(hr[offB]) : 0.f; b2[u] = hasB ? bf2f(hr[offB + 8]) : 0.f;
    }
    {
      float* csl = (float*)smem;
      __syncthreads();
      if (tid5 < 2 * NB * 24) {
        const int hf = tid5 / (NB * 24), rem = tid5 - hf * (NB * 24), uu2 = rem / 24, f = rem - uu2 * 24;
        int tk = (tok0 - (tid5 >> 8)) + hf + uu2 * gs; tk = tk < NTOK ? tk : 0;
        const float ang = (float)p.pos[tk] * (f < 16 ? c_invf32[f] : c_invf16[f - 16]);
        csl[tid5 * 2] = cosf(ang); csl[tid5 * 2 + 1] = sinf(ang);
      }
      __syncthreads();
    }
#pragma unroll
    for (int u = 0; u < NB; ++u) {
      const int tok = tok0 + u * gs;
      if (tok < NTOK) {
        const u16* hr = H + (size_t)tok * HLD;
        const int t = tok & (S_ - 1);
        const int cnt = (t + 1 < w) ? (t + 1) : w;
        float s0 = 0.f, s1 = 0.f, s2 = 0.f, s3 = 0.f;
        for (int i = 0; i < cnt; ++i) {
          const uint2 v = *(const uint2*)(hr - (size_t)i * HLD + c0);
          s0 += bflo(v.x); s1 += bfhi(v.x); s2 += bflo(v.y); s3 += bfhi(v.y);
        }
        const uint2 uu = *(const uint2*)(hr + c0);
        const float ic = 1.f / (float)cnt;
        uint2 o; o.x = pk2(s0 * ic - bflo(uu.x), s1 * ic - bfhi(uu.x)); o.y = pk2(s2 * ic - bflo(uu.y), s3 * ic - bfhi(uu.y));
        *(uint2*)(DP + (size_t)tok * 1024 + c0) = o;
      }
    }
#pragma unroll
    for (int u = 0; u < NB; ++u) {
      const int tok = tok0 + u * gs;
      if (tok < NTOK) {
        u16* hr = H + (size_t)tok * HLD;
        const float* cst = (const float*)smem + (((tid5 >> 8) * NB + u) * 24) * 2;
        {
          const float cs = cst[fiA * 2], sn = cst[fiA * 2 + 1];
          hr[offA] = f2bf(a1[u] * cs - a2[u] * sn); hr[offA + 16] = f2bf(a2[u] * cs + a1[u] * sn);
        }
        if (hasB) {
          const float cs = cst[fiB * 2], sn = cst[fiB * 2 + 1];
          hr[offB] = f2bf(b1[u] * cs - b2[u] * sn); hr[offB + 8] = f2bf(b2[u] * cs + b1[u] * sn);
        }
      }
    }
  }
}

DI void prep_odd(const Params& p, int j, char* smem) {
  const u16* H = (const u16*)(p.ws + O_H); u16* CAT = (u16*)(p.ws + O_CAT);
  const float* AUX = (const float*)(p.ws + O_AUX); float* FC = (float*)(p.ws + O_FC);
  const int tid5 = TID, tid = tid5 & 255;
  for (int seq = BID; seq < 16; seq += gridDim.x) {
    const int b = seq >> 3, hd = seq & 7;
    const float fb = p.od_forget_b[j * 8 + hd];
    float* part = (float*)smem;
    float loc[16]; float run = 0.f;
#pragma unroll
    for (int i = 0; i < 16; ++i) {
      const float xv = AUX[(size_t)(b * S_ + tid5 * 16 + i) * 16 + hd] + fb;
      const float lf = fminf(xv, 0.f) - log1pf(__expf(-fabsf(xv)));
      run += lf; loc[i] = run;
    }
    const int ln = tid5 & 63, wv8 = tid5 >> 6;
    float incl = run;
#pragma unroll
    for (int d = 1; d < 64; d <<= 1) {
      const float t = __int_as_float(__builtin_amdgcn_ds_bpermute(((ln - d) & 63) << 2, __float_as_int(incl)));
      if (ln >= d) incl += t;
    }
    if (ln == 63) part[wv8] = incl;
    __syncthreads();
    float off = incl - run;
    for (int w = 0; w < wv8; ++w) off += part[w];
#pragma unroll
    for (int i = 0; i < 16; ++i) FC[(size_t)seq * S_ + tid5 * 16 + i] = (off + loc[i]) * LOG2E;
    __syncthreads();
  }
  const float* cw = p.od_conv_w + (size_t)j * 3 * 1024;
  const int c0 = tid * 4;
  const f32x4 w0 = *(const f32x4*)(cw + c0), w1 = *(const f32x4*)(cw + 1024 + c0), w2 = *(const f32x4*)(cw + 2048 + c0);
  float knmax = 0.f; const int lane_ = tid5 & 63;
  const int gs = gridDim.x * 2;
  constexpr int NB = 4;
  for (int tok0 = BID * 2 + (tid5 >> 8); tok0 < NTOK; tok0 += gs * NB) {
    uint2 uu[NB][3], gc[NB][3], gb[NB], kk[NB];
#pragma unroll
    for (int u = 0; u < NB; ++u) {
      const int tok = tok0 + u * gs; const bool ok = tok < NTOK;
      const int t = tok & (S_ - 1);
      const u16* hr = H + (size_t)(ok ? tok : 0) * HLD;
#pragma unroll
      for (int k = 0; k < 3; ++k) {
        const int back = 2 - k;
        const bool v = ok && (t - back >= 0);
        const u16* hp = hr - (size_t)(v ? back : 0) * HLD;
        uu[u][k] = *(const uint2*)(hp + c0); gc[u][k] = *(const uint2*)(hp + 2048 + c0);
        if (!v) { uu[u][k] = make_uint2(0u, 0u); gc[u][k] = make_uint2(0u, 0u); }
      }
      gb[u] = *(const uint2*)(hr + 1024 + c0);
      kk[u] = *(const uint2*)(hr + 4096 + c0);
      if (!ok) kk[u] = make_uint2(0u, 0u);
    }
#pragma unroll
    for (int u = 0; u < NB; ++u) {
      const int tok = tok0 + u * gs;
      {
        float ks = bflo(kk[u].x) * bflo(kk[u].x) + bfhi(kk[u].x) * bfhi(kk[u].x) + bflo(kk[u].y) * bflo(kk[u].y) + bfhi(kk[u].y) * bfhi(kk[u].y);
#pragma unroll
        for (int o = 16; o > 0; o >>= 1) ks += shflx(ks, o, lane_);
        knmax = fmaxf(knmax, ks);
      }
      float a0 = 0.f, a1 = 0.f, a2 = 0.f, a3 = 0.f;
#pragma unroll
      for (int k = 0; k < 3; ++k) {
        const f32x4 ww = (k == 0) ? w0 : (k == 1) ? w1 : w2;
        a0 += ww[0] * bflo(uu[u][k].x) * bflo(gc[u][k].x); a1 += ww[1] * bfhi(uu[u][k].x) * bfhi(gc[u][k].x);
        a2 += ww[2] * bflo(uu[u][k].y) * bflo(gc[u][k].y); a3 += ww[3] * bfhi(uu[u][k].y) * bfhi(gc[u][k].y);
      }
      if (tok < NTOK) {
        uint2 o; o.x = pk2(a0 * bflo(gb[u].x), a1 * bfhi(gb[u].x)); o.y = pk2(a2 * bflo(gb[u].y), a3 * bfhi(gb[u].y));
        *(uint2*)(CAT + (size_t)tok * DM + c0) = o;
      }
    }
  }
  if ((lane_ & 31) == 0) atomicMax((unsigned*)(p.ws + O_BAR) + KN_WORD0 + j * 8 + (tid >> 5), __float_as_uint(knmax));
}

DI void ln_phase(const Params& p, const float* g, const float* bta, float* outf) {
  const float* Y = (const float*)(p.ws + O_Y); u16* XB = (u16*)(p.ws + O_XB);
  const int tid_ = TID; const int lane = tid_ & 63, wave = tid_ >> 6;
  const int nw = gridDim.x * NWAVE, gw = BID * NWAVE + wave;
  for (int row = gw; row < NTOK; row += nw) {
    const float* yr = Y + (size_t)row * DM;
    float4 v[8]; float s = 0.f;
#pragma unroll
    for (int i = 0; i < 8; ++i) { v[i] = *(const float4*)(yr + (i * 64 + lane) * 4); s += v[i].x + v[i].y + v[i].z + v[i].w; }
#pragma unroll
    for (int o = 32; o > 0; o >>= 1) s += shflx(s, o, lane);
    const float mu = s * (1.f / DM);
    float q = 0.f;
#pragma unroll
    for (int i = 0; i < 8; ++i) { float a = v[i].x - mu, b = v[i].y - mu, c = v[i].z - mu, d = v[i].w - mu; q += a * a + b * b + c * c + d * d; }
#pragma unroll
    for (int o = 32; o > 0; o >>= 1) q += shflx(q, o, lane);
    const float rs = rsqrtf(q * (1.f / DM) + 1e-5f);
#pragma unroll
    for (int i = 0; i < 8; ++i) {
      const int c = (i * 64 + lane) * 4;
      const float4 gg = *(const float4*)(g + c), bb = *(const float4*)(bta + c);
      float4 o4;
      o4.x = (v[i].x - mu) * rs * gg.x + bb.x; o4.y = (v[i].y - mu) * rs * gg.y + bb.y;
      o4.z = (v[i].z - mu) * rs * gg.z + bb.z; o4.w = (v[i].w - mu) * rs * gg.w + bb.w;
      *(float4*)(outf + (size_t)row * DM + c) = o4;
      uint2 ob; ob.x = pk2(o4.x, o4.y); ob.y = pk2(o4.z, o4.w);
      *(uint2*)(XB + (size_t)row * DM + c) = ob;
    }
  }
}


constexpr int PH_PER_LAYER = 14;
constexpr int N_PHASES = 1 + 4 * PH_PER_LAYER;

DI void run_phase(const Params& p, int ph, char* smem) {
  char* ws = p.ws;
  const u16* XB = (const u16*)(ws + O_XB);
  float* XF = (float*)(ws + O_XF);
  if (ph == 0) { convert_phase(p, smem); return; }
  const int L = (ph - 1) / PH_PER_LAYER, sp = (ph - 1) % PH_PER_LAYER;
  const int j = L >> 1; const bool even = (L & 1) == 0;
  const float* resid = (L == 0) ? p.x : nullptr;
  const GemmP gz = mk_gemm(nullptr, 0, nullptr, 0, 0, 0, 0);
  switch (sp) {
    case 0: {
      GemmP g1 = mk_gemm(XB, DM, (const u16*)(ws + (even ? O_EVIN + j * SZ_EVIN : O_ODIN + j * SZ_ODIN)), DM, DM, 64, even ? EV_N / 256 : OD_N / 256);
      g1.Cb = (u16*)(ws + O_H); g1.ldc = HLD; g1.aux = (float*)(ws + O_AUX);
      if (even) { g1.aux_n0 = 4160; g1.aux_cnt = 16; g1.aux_scale = 0.25f; } else { g1.aux_n0 = 5120; g1.aux_cnt = 8; g1.aux_scale = 1.f; }
      GemmP g2 = mk_gemm((const u16*)(ws + (even ? O_EVV : O_ODV) + j * SZ_V), DM, XB, DM, DM, 4, 64);
      g2.Cb = (u16*)(ws + O_VT); g2.ldc = S_; g2.vt_S = S_; g2.vt_bstride = 1024 * S_;
      {
        const int n1 = g1.Mt * g1.Nt, n2 = g2.Mt * g2.Nt, nm = (L == 0) ? 32 : 0, G = gridDim.x;
        bool pre = false;
        for (int U = BID; U < n1 + n2 + nm; U += G) {
          int pm, pn, pm2 = 0, pn2 = 0;
          const int Un = U + G;
          if (U < n1) {
            unit_of(U, g1.Mt, g1.Nt, pm, pn);
            gemm_unit<EPI_BF16>(g1, pm, pn);
          } else if (U < n1 + n2) {
            unit_of(U - n1, g2.Mt, g2.Nt, pm, pn);
            gemm_unit<EPI_VT>(g2, pm, pn);
          } else {
            const int t = U - n1 - n2;
            const int layer = t >> 3, kind = (t >> 2) & 1, m = (t >> 1) & 1, n = t & 1;
            const u16* MB = (const u16*)(ws + O_MEMB);
            if (kind == 0) {
              GemmP g = mk_gemm(MB, DM, (const u16*)(ws + O_CAK + layer * SZ_CA), DM, DM, 2, 2);
              g.Cb = (u16*)(ws + O_MEMK) + (size_t)layer * 512 * 512; g.ldc = 512;
              gemm_unit<EPI_BF16>(g, m, n);
            } else {
              GemmP g = mk_gemm((const u16*)(ws + O_CAV + layer * SZ_CA), DM, MB, DM, DM, 2, 2);
              g.Cb = (u16*)(ws + O_MEMVT) + (size_t)layer * 512 * 512; g.ldc = 256; g.vt_S = 256; g.vt_bstride = 512 * 256;
              gemm_unit<EPI_VT>(g, m, n);
            }
          }
          (void)pre; (void)pm2; (void)pn2; (void)Un;
        }
      }
    } break;
    case 1: if (even) prep_even(p, j, smem); else prep_odd(p, j, smem); break;
    case 2: if (even) {
      score_phase(p, smem);
      for (int t = BID; t < 4 * 64; t += gridDim.x) {
        const int m = t & 63, grp = t >> 6;
        GemmP g = mk_gemm((const u16*)(ws + O_DP) + grp * 256, 1024, (const u16*)(ws + O_POOL) + (size_t)(j * 4 + grp) * 256 * 256, 256, 256, 64, 1);
        g.Cb = (u16*)(ws + O_CAT) + grp * 256; g.ldc = DM; g.colscale = p.ev_pool_scale + j * 1024 + grp * 256;
        gemm_unit<EPI_BF16>(g, m, 0);
      }
    } break;
    case 3: if (even) select_phase(p); break;
    case 4: if (even) self_attn_phase<2>(p, 1024, 2048, j, smem); else self_attn_phase<1>(p, 3072, 4096, j, smem); break;
    case 5: {
      GemmP g1 = mk_gemm((const u16*)(ws + O_CAT), DM, (const u16*)(ws + (even ? O_EVOUT : O_ODOUT) + j * SZ_SQ), DM, DM, 64, 8);
      g1.R = resid; g1.ln_g = p.ln_g + (size_t)(L * 3 + 0) * DM; g1.ln_b = p.ln_b + (size_t)(L * 3 + 0) * DM;
      g1.outf = nullptr; g1.outb = (u16*)(ws + O_XB); g1.stats = (u64*)(ws + O_STATS) + (size_t)(L * 3 + 0) * 64 * 8 * 256;
      g1.cnt = (unsigned*)(ws + O_BAR) + CNT_WORD0 + (L * 3 + 0) * 64; g1.bar = (unsigned*)(ws + O_BAR);
      gemm_phase_ln(g1);
    } break;
    case 7: {
      GemmP g1 = mk_gemm(XB, DM, (const u16*)(ws + O_CAQ + L * SZ_CA), DM, DM, 64, 2);
      g1.Cb = (u16*)(ws + O_CQ); g1.ldc = 512;
      gemm_phase2<EPI_BF16, EPI_BF16>(g1, gz, smem);
    } break;
    case 8: cross_attn_phase(p, L, smem); break;
    case 9: {
      GemmP g1 = mk_gemm((const u16*)(ws + O_CO), 512, (const u16*)(ws + O_CAO + L * SZ_CA), 512, 512, 64, 8);
      g1.R = nullptr; g1.ln_g = p.ln_g + (size_t)(L * 3 + 1) * DM; g1.ln_b = p.ln_b + (size_t)(L * 3 + 1) * DM;
      g1.outf = nullptr; g1.outb = (u16*)(ws + O_XB); g1.stats = (u64*)(ws + O_STATS) + (size_t)(L * 3 + 1) * 64 * 8 * 256;
      g1.cnt = (unsigned*)(ws + O_BAR) + CNT_WORD0 + (L * 3 + 1) * 64; g1.bar = (unsigned*)(ws + O_BAR);
      gemm_phase_ln(g1);
    } break;
    case 11: {
      GemmP g1 = mk_gemm(XB, DM, (const u16*)(ws + O_FFIN + L * SZ_FFIN), DM, DM, 64, 44);
      g1.Cb = (u16*)(ws + O_HID); g1.ldc = FFH;
      gemm_phase2<EPI_SWIGLU, EPI_SWIGLU>(g1, gz, smem);
    } break;
    case 12: {
      GemmP g1 = mk_gemm((const u16*)(ws + O_HID), FFH, (const u16*)(ws + O_FFOUT + L * SZ_FFOUT), FFH, FFH, 64, 8);
      g1.R = nullptr; g1.ln_g = p.ln_g + (size_t)(L * 3 + 2) * DM; g1.ln_b = p.ln_b + (size_t)(L * 3 + 2) * DM;
      g1.outf = (L == 3) ? p.out : nullptr; g1.outb = (u16*)(ws + O_XB); g1.stats = (u64*)(ws + O_STATS) + (size_t)(L * 3 + 2) * 64 * 8 * 256;
      g1.cnt = (unsigned*)(ws + O_BAR) + CNT_WORD0 + (L * 3 + 2) * 64; g1.bar = (unsigned*)(ws + O_BAR);
      gemm_phase_ln(g1);
    } break;
  }
}

typedef const Params __attribute__((address_space(4))) * KParamsP;
__global__ void __launch_bounds__(512, 2) mega(Params p_unused, int ph_lo, int ph_hi, int coop) {
  char* smem = dynsmem;
  cg::grid_group grid = cg::this_grid();
  volatile LAS unsigned* st = (volatile LAS unsigned*)(dynsmem + 131072);
  if (threadIdx.x == 0) { st[0] = 0u; st[1] = 0u; }
  __syncthreads();
#if defined(__HIP_DEVICE_COMPILE__)
  {
    KParamsP kp0 = (KParamsP)__builtin_amdgcn_kernarg_segment_ptr();
    unsigned* bar0 = (unsigned*)(kp0->ws + O_BAR);
    if (threadIdx.x == 0) (void)xb_add(&bar0[XB_XCNT(xb_xcc_id())], 1u);
  }
#endif
  for (int ph = ph_lo; ph < ph_hi; ++ph) {
    const int sp = (ph - 1) % PH_PER_LAYER, L = (ph - 1) / PH_PER_LAYER;
    const bool skip = (ph > 0) && (((L & 1) && (sp == 2 || sp == 3)) || sp == 6 || sp == 10 || sp == 13);
    if (skip) continue;
#if defined(__HIP_DEVICE_COMPILE__)
    {
      KParamsP kp = (KParamsP)__builtin_amdgcn_kernarg_segment_ptr();
      asm volatile("" : "+s"(kp));
      const Params lp = *kp;
      run_phase(lp, ph, smem);
      if (coop && ph + 1 < N_PHASES - 1) {
        if (coop == 2) grid.sync();
        else { XcdBarrier b; b.bar = (unsigned*)(lp.ws + O_BAR); b.x = xb_xcc_id(); b.st = st; xcd_barrier(b); }
      }
    }
#endif
  }
}

extern "C" void kernel_launch(void* const* d_in, const int* in_sizes, int n_in, void* d_out, int out_size, void* d_ws, size_t ws_size,
                              hipStream_t stream) {
  static int grid_blocks = 0;
  if (!grid_blocks) {
    int dev = 0, cus = 0, per_cu = 0;
    hipGetDevice(&dev);
    hipDeviceGetAttribute(&cus, hipDeviceAttributeMultiprocessorCount, dev);
    hipFuncSetAttribute((const void*)mega, hipFuncAttributeMaxDynamicSharedMemorySize, LDS_BYTES);
    hipOccupancyMaxActiveBlocksPerMultiprocessor(&per_cu, (const void*)mega, NTHR, LDS_BYTES);
    if (per_cu > 1) per_cu = 1;
    if (per_cu < 1) per_cu = 1;
    grid_blocks = cus * per_cu;
    if (ws_size < WS_TOTAL) fprintf(stderr, "kernel_launch: workspace too small: %zu < %zu\n", ws_size, (size_t)WS_TOTAL);
    fprintf(stderr, "kernel_launch: grid %d (cus %d x %d)\n", grid_blocks, cus, per_cu);
  }
  hipMemsetAsync((char*)d_ws + O_BAR, 0, 32768, stream);
  Params p{};
  p.x = (const float*)d_in[0]; p.mem = (const float*)d_in[1]; p.pos = (const int*)d_in[2];
  p.ev_w_in = (const float*)d_in[3]; p.ev_pool_w = (const float*)d_in[4]; p.ev_pool_scale = (const float*)d_in[5]; p.ev_w_out = (const float*)d_in[6];
  p.od_w_in = (const float*)d_in[7]; p.od_conv_w = (const float*)d_in[8]; p.od_forget_b = (const float*)d_in[9]; p.od_w_out = (const float*)d_in[10];
  p.ca_w_q = (const float*)d_in[11]; p.ca_w_kv = (const float*)d_in[12]; p.ca_w_o = (const float*)d_in[13];
  p.ffn_w_in = (const float*)d_in[14]; p.ffn_w_out = (const float*)d_in[15]; p.ln_g = (const float*)d_in[16]; p.ln_b = (const float*)d_in[17];
  p.out = (float*)d_out; p.ws = (char*)d_ws;
  int lo = 0, hi = N_PHASES, coop = 1;
  void* args[] = {&p, &lo, &hi, &coop};
  hipError_t e = hipLaunchCooperativeKernel((const void*)mega, dim3(grid_blocks), dim3(NTHR), args, LDS_BYTES, stream);
  if (e != hipSuccess) fprintf(stderr, "cooperative launch failed: %s (grid %d)\n", hipGetErrorString(e), grid_blocks);
}
```

```cpp
#include <hip/hip_runtime.h>
#include <hip/hip_cooperative_groups.h>
#include <stdint.h>
#include <stdio.h>
#include <math.h>
namespace cg = cooperative_groups;

#define DI __device__ __forceinline__
typedef unsigned short u16;
typedef unsigned long long u64;
typedef short bf16x8 __attribute__((ext_vector_type(8)));
typedef float f32x16 __attribute__((ext_vector_type(16)));
typedef unsigned u32x4 __attribute__((ext_vector_type(4)));
typedef float f32x4 __attribute__((ext_vector_type(4)));
#define MFMA(a, b, c) __builtin_amdgcn_mfma_f32_32x32x16_bf16((a), (b), (c), 0, 0, 0)

constexpr int S_ = 8192, NTOK = 16384, DM = 2048;
constexpr int HLD = 5376;
constexpr int EV_N = 4352, OD_N = 5376;
constexpr int FFH = 5632;
constexpr float ALPHA_ = 1.6817928305074290f;
constexpr float LOG2E = 1.4426950408889634f;
constexpr int SCB = 2048 * 128 * 129;

constexpr size_t al256(size_t x) { return (x + 255) & ~(size_t)255; }
constexpr size_t SZ_EVIN = (size_t)EV_N * 2048 * 2, SZ_V = (size_t)1024 * 2048 * 2, SZ_SQ = (size_t)2048 * 2048 * 2;
constexpr size_t SZ_POOL = (size_t)4 * 256 * 256 * 2, SZ_ODIN = (size_t)OD_N * 2048 * 2;
constexpr size_t SZ_CA = (size_t)512 * 2048 * 2, SZ_FFIN = (size_t)11264 * 2048 * 2, SZ_FFOUT = (size_t)2048 * FFH * 2;
constexpr size_t O_EVIN = 0;
constexpr size_t O_EVV = O_EVIN + 2 * SZ_EVIN;
constexpr size_t O_EVOUT = O_EVV + 2 * SZ_V;
constexpr size_t O_POOL = O_EVOUT + 2 * SZ_SQ;
constexpr size_t O_ODIN = O_POOL + 2 * SZ_POOL;
constexpr size_t O_ODV = O_ODIN + 2 * SZ_ODIN;
constexpr size_t O_ODOUT = O_ODV + 2 * SZ_V;
constexpr size_t O_CAQ = O_ODOUT + 2 * SZ_SQ;
constexpr size_t O_CAK = O_CAQ + 4 * SZ_CA;
constexpr size_t O_CAV = O_CAK + 4 * SZ_CA;
constexpr size_t O_CAO = O_CAV + 4 * SZ_CA;
constexpr size_t O_FFIN = O_CAO + 4 * SZ_CA;
constexpr size_t O_FFOUT = O_FFIN + 4 * SZ_FFIN;
constexpr size_t O_XB = O_FFOUT + 4 * SZ_FFOUT;
constexpr size_t O_XF = O_XB + (size_t)NTOK * DM * 2;
constexpr size_t O_MEMB = O_XF + (size_t)NTOK * DM * 4;
constexpr size_t O_MEMK = O_MEMB + (size_t)512 * 2048 * 2;
constexpr size_t O_MEMVT = O_MEMK + (size_t)4 * 512 * 512 * 2;
constexpr size_t O_H = O_MEMVT + (size_t)4 * 512 * 512 * 2;
constexpr size_t O_VT = O_H + (size_t)NTOK * HLD * 2;
constexpr size_t O_CAT = O_VT + (size_t)2 * 1024 * S_ * 2;
constexpr size_t O_DP = O_CAT + (size_t)NTOK * DM * 2;
constexpr size_t O_AUX = O_DP + (size_t)NTOK * 1024 * 2;
constexpr size_t O_FC = O_AUX + (size_t)NTOK * 16 * 4;
constexpr size_t O_BM = O_FC + (size_t)16 * S_ * 4;
constexpr size_t O_CQ = O_BM + (size_t)NTOK * 256 * 4;
constexpr size_t O_CO = O_CQ + (size_t)NTOK * 512 * 2;
constexpr size_t O_Y = O_CO + (size_t)NTOK * 512 * 2;
constexpr size_t O_HID = O_Y + (size_t)NTOK * DM * 4;
constexpr size_t O_SC = O_Y;
constexpr size_t O_BAR = O_HID + (size_t)NTOK * FFH * 2;
constexpr size_t O_STATS = O_BAR + 32768;
constexpr size_t WS_TOTAL = O_STATS + (size_t)12 * 64 * 8 * 256 * 8;
constexpr int KN_WORD0 = 8000;
constexpr int CNT_WORD0 = 3456;
static_assert((size_t)2 * SCB * 4 <= (size_t)NTOK * DM * 4 + (size_t)NTOK * FFH * 2, "score alias too small");

constexpr int LDS_BYTES = 131072 + 64 + 1024 + 64;
constexpr int NTHR = 512, NWAVE = 8;
extern __shared__ __attribute__((aligned(1024))) char dynsmem[];

struct Params {
  const float* x; const float* mem; const int* pos;
  const float* ev_w_in; const float* ev_pool_w; const float* ev_pool_scale; const float* ev_w_out;
  const float* od_w_in; const float* od_conv_w; const float* od_forget_b; const float* od_w_out;
  const float* ca_w_q; const float* ca_w_kv; const float* ca_w_o; const float* ffn_w_in; const float* ffn_w_out;
  const float* ln_g; const float* ln_b;
  float* out; char* ws;
};
__constant__ float c_invf32[16] = {1.000000000e+00f, 4.403666027e-01f, 1.939227447e-01f, 8.539710029e-02f, 3.760603093e-02f, 1.656044008e-02f, 7.292664737e-03f, 3.211445995e-03f, 1.414213562e-03f, 6.227724219e-04f, 2.742481757e-04f, 1.207697374e-04f, 5.318295897e-05f, 2.341999896e-05f, 1.031338538e-05f, 4.541670481e-06f};
__constant__ float c_invf16[8] = {1.000000000e+00f, 1.939227447e-01f, 3.760603093e-02f, 7.292664737e-03f, 1.414213562e-03f, 2.742481757e-04f, 5.318295897e-05f, 1.031338538e-05f};

DI unsigned pk2(float a, float b) {
  typedef __bf16 b2 __attribute__((ext_vector_type(2)));
  typedef float f2 __attribute__((ext_vector_type(2)));
  f2 v = {a, b};
  b2 r = __builtin_convertvector(v, b2);
  return __builtin_bit_cast(unsigned, r);
}
DI int opq(int v) { asm volatile("" : "+v"(v)); return v; }
DI int opqs(int v) { asm volatile("" : "+s"(v)); return v; }
#define TID opq((int)threadIdx.x)
#define BID opqs((int)blockIdx.x)
DI float shflx(float v, int m, int lane) { return __int_as_float(__builtin_amdgcn_ds_bpermute((lane ^ m) << 2, __float_as_int(v))); }
DI int shflxi(int v, int m, int lane) { return __builtin_amdgcn_ds_bpermute((lane ^ m) << 2, v); }
DI u16 f2bf(float a) { return (u16)(pk2(a, 0.f) & 0xffffu); }
DI float bf2f(u16 v) { return __uint_as_float(((unsigned)v) << 16); }
DI float bflo(unsigned v) { return __uint_as_float(v << 16); }
DI float bfhi(unsigned v) { return __uint_as_float(v & 0xffff0000u); }

struct CJob { const float* src; int K; int lds; u16* dst; int rows; int n1; int off1; int n2; int off2; int ffn; };

DI CJob get_job(const Params& p, int id) {
  CJob j; j.ffn = 0; j.n2 = 0; j.off2 = 0; j.off1 = 0;
  char* ws = p.ws;
  if (id < 2) {
    j.src = p.ev_w_in + (size_t)id * 2048 * 5200; j.K = 2048; j.lds = 5200; j.dst = (u16*)(ws + O_EVIN + id * SZ_EVIN); j.rows = EV_N;
    j.n1 = 3072; j.off1 = 0; j.n2 = 4176; j.off2 = 1024;
  } else if (id < 4) {
    int l = id - 2; j.src = p.ev_w_in + (size_t)l * 2048 * 5200; j.K = 2048; j.lds = 5200; j.dst = (u16*)(ws + O_EVV + l * SZ_V); j.rows = 1024;
    j.n1 = 1024; j.off1 = 3072;
  } else if (id < 6) {
    int l = id - 4; j.src = p.ev_w_out + (size_t)l * 2048 * 2048; j.K = 2048; j.lds = 2048; j.dst = (u16*)(ws + O_EVOUT + l * SZ_SQ); j.rows = 2048; j.n1 = 2048;
  } else if (id < 14) {
    int l = id - 6; j.src = p.ev_pool_w + (size_t)l * 256 * 256; j.K = 256; j.lds = 256; j.dst = (u16*)(ws + O_POOL) + (size_t)l * 256 * 256; j.rows = 256; j.n1 = 256;
  } else if (id < 16) {
    int l = id - 14; j.src = p.od_w_in + (size_t)l * 2048 * 6152; j.K = 2048; j.lds = 6152; j.dst = (u16*)(ws + O_ODIN + l * SZ_ODIN); j.rows = OD_N;
    j.n1 = 5120; j.off1 = 0; j.n2 = 5128; j.off2 = 1024;
  } else if (id < 18) {
    int l = id - 16; j.src = p.od_w_in + (size_t)l * 2048 * 6152; j.K = 2048; j.lds = 6152; j.dst = (u16*)(ws + O_ODV + l * SZ_V); j.rows = 1024; j.n1 = 1024; j.off1 = 5120;
  } else if (id < 20) {
    int l = id - 18; j.src = p.od_w_out + (size_t)l * 2048 * 2048; j.K = 2048; j.lds = 2048; j.dst = (u16*)(ws + O_ODOUT + l * SZ_SQ); j.rows = 2048; j.n1 = 2048;
  } else if (id < 24) {
    int l = id - 20; j.src = p.ca_w_q + (size_t)l * 2048 * 512; j.K = 2048; j.lds = 512; j.dst = (u16*)(ws + O_CAQ + l * SZ_CA); j.rows = 512; j.n1 = 512;
  } else if (id < 28) {
    int l = id - 24; j.src = p.ca_w_kv + (size_t)l * 2048 * 1024; j.K = 2048; j.lds = 1024; j.dst = (u16*)(ws + O_CAK + l * SZ_CA); j.rows = 512; j.n1 = 512;
  } else if (id < 32) {
    int l = id - 28; j.src = p.ca_w_kv + (size_t)l * 2048 * 1024; j.K = 2048; j.lds = 1024; j.dst = (u16*)(ws + O_CAV + l * SZ_CA); j.rows = 512; j.n1 = 512; j.off1 = 512;
  } else if (id < 36) {
    int l = id - 32; j.src = p.ca_w_o + (size_t)l * 512 * 2048; j.K = 512; j.lds = 2048; j.dst = (u16*)(ws + O_CAO + l * SZ_CA); j.rows = 2048; j.n1 = 2048;
  } else if (id < 40) {
    int l = id - 36; j.src = p.ffn_w_in + (size_t)l * 2048 * 11264; j.K = 2048; j.lds = 11264; j.dst = (u16*)(ws + O_FFIN + l * SZ_FFIN); j.rows = 11264; j.n1 = 11264; j.ffn = 1;
  } else {
    int l = id - 40; j.src = p.ffn_w_out + (size_t)l * FFH * 2048; j.K = FFH; j.lds = 2048; j.dst = (u16*)(ws + O_FFOUT + l * SZ_FFOUT); j.rows = 2048; j.n1 = 2048;
  }
  return j;
}
constexpr int NJOBS = 44;

DI void convert_phase(const Params& p, char* smem) {
  const int tid5 = TID, half = tid5 >> 8, tid = tid5 & 255;
  constexpr int NU = 3;
  float* tile0 = (float*)smem + half * NU * (64 * 65);
  int* pre = (int*)(smem + 120000);
  if (tid5 < NJOBS) { const CJob j = get_job(p, tid5); pre[64 + tid5] = (j.rows >> 6) * (j.K >> 6); }
  __syncthreads();
  if (tid5 == 0) { int a = 0; for (int i = 0; i < NJOBS; ++i) { pre[i] = a; a += pre[64 + i]; } pre[NJOBS] = a; }
  __syncthreads();
  const int total = pre[NJOBS];
  int jc = 0;
  for (int tb = BID * 2 * NU; tb < total; tb += gridDim.x * 2 * NU) {
    const int rr = tid & 63, kq = tid >> 6;
    float v[NU][16];
    u16* dstp[NU]; int dK[NU];
#pragma unroll
    for (int u = 0; u < NU; ++u) {
      const int tg = tb + half * NU + u; const bool valid = tg < total;
      while (valid && tg >= pre[jc + 1]) ++jc;
      const CJob j = get_job(p, jc);
      const int t = valid ? (tg - pre[jc]) : 0;
      const int kt_n = j.K >> 6;
      const int rt = t / kt_n, kt = t - rt * kt_n;
      const int r = rt * 64 + rr, k0 = kt * 64;
      int c;
      if (j.ffn) { int tt = r >> 8, w = r & 255; c = (w < 128) ? tt * 128 + w : FFH + tt * 128 + (w - 128); }
      else c = (r < j.n1) ? r + j.off1 : ((r < j.n2) ? r + j.off2 : -1);
      const float* sp = j.src + (size_t)(k0 + kq) * j.lds + (c < 0 ? 0 : c);
#pragma unroll
      for (int i = 0; i < 16; ++i) v[u][i] = (valid && c >= 0) ? sp[(size_t)(4 * i) * j.lds] : 0.f;
      dstp[u] = valid ? (j.dst + (size_t)(rt * 64) * j.K + k0) : nullptr; dK[u] = j.K;
    }
#pragma unroll
    for (int u = 0; u < NU; ++u) {
      float* tile = tile0 + u * (64 * 65);
#pragma unroll
      for (int i = 0; i < 16; ++i) tile[(kq + 4 * i) * 65 + rr] = v[u][i];
    }
    __syncthreads();
#pragma unroll
    for (int u = 0; u < NU; ++u) {
      if (dstp[u]) {
        const float* tile = tile0 + u * (64 * 65);
#pragma unroll
        for (int i = 0; i < 2; ++i) {
          const int q = tid + 256 * i, row = q >> 3, ch = q & 7;
          float w[8];
#pragma unroll
          for (int e = 0; e < 8; ++e) w[e] = tile[(ch * 8 + e) * 65 + row];
          u32x4 o; o[0] = pk2(w[0], w[1]); o[1] = pk2(w[2], w[3]); o[2] = pk2(w[4], w[5]); o[3] = pk2(w[6], w[7]);
          *(u32x4*)(dstp[u] + (size_t)row * dK[u] + ch * 8) = o;
        }
      }
    }
    __syncthreads();
  }
  {
    u32x4* zp = (u32x4*)(p.ws + O_STATS); const u32x4 z = {0u, 0u, 0u, 0u};
    const size_t nz = (size_t)12 * 64 * 8 * 256 * 8 / 16;
    for (size_t i = (size_t)BID * NTHR + tid5; i < nz; i += (size_t)gridDim.x * NTHR) zp[i] = z;
  }
  {
    const size_t gtid = (size_t)BID * NTHR + tid5, gstride = (size_t)gridDim.x * NTHR;
    u16* xb = (u16*)(p.ws + O_XB); u16* mb = (u16*)(p.ws + O_MEMB);
    const size_t n1 = (size_t)NTOK * DM / 8, n2 = (size_t)512 * DM / 8;
    for (size_t i0 = gtid; i0 < n1 + n2; i0 += gstride * 4) {
      f32x4 a[4], b[4];
#pragma unroll
      for (int u = 0; u < 4; ++u) {
        const size_t i = i0 + u * gstride;
        if (i < n1 + n2) { const float* sp = (i < n1) ? p.x + i * 8 : p.mem + (i - n1) * 8; a[u] = *(const f32x4*)sp; b[u] = *(const f32x4*)(sp + 4); }
      }
#pragma unroll
      for (int u = 0; u < 4; ++u) {
        const size_t i = i0 + u * gstride;
        if (i < n1 + n2) {
          u16* d = (i < n1) ? xb + i * 8 : mb + (i - n1) * 8;
          u32x4 o; o[0] = pk2(a[u][0], a[u][1]); o[1] = pk2(a[u][2], a[u][3]); o[2] = pk2(b[u][0], b[u][1]); o[3] = pk2(b[u][2], b[u][3]);
          *(u32x4*)d = o;
        }
      }
    }
  }
}

#define XB_TMO      128
#define XB_XCNT(j)  (256  + 64 * (j))
#define XB_XSUB(j)  (1280 + 64 * (j))
#define XB_XGEN(j)  (2304 + 64 * (j))
#define XB_TOP      3328
#define XB_TOPGEN   3392
#define XCD_BAR_WORDS 3456
#define XB_SPIN_CAP (1u << 22)
#define LAS __attribute__((address_space(3)))
DI unsigned xb_ld(unsigned* p)              { return __hip_atomic_load(p, __ATOMIC_RELAXED, __HIP_MEMORY_SCOPE_AGENT); }
DI unsigned xb_add(unsigned* p, unsigned v) { return __hip_atomic_fetch_add(p, v, __ATOMIC_RELAXED, __HIP_MEMORY_SCOPE_AGENT); }
DI unsigned xb_xcc_id() { return (unsigned)__builtin_amdgcn_s_getreg((3 << 11) | 20) & 0xFu; }
#define XB_SPIN(cond, bar) do { unsigned _sp = 0; while (cond) { __builtin_amdgcn_s_sleep(1); \
    if ((++_sp & 255u) == 0u) { if (xb_ld(&(bar)[XB_TMO])) break; if (_sp > XB_SPIN_CAP) { atomicAdd(&(bar)[XB_TMO], 1u); break; } } } } while (0)
struct XcdBarrier { unsigned* bar; unsigned x; volatile LAS unsigned* st; };
DI void xcd_barrier_complete(unsigned* bar, unsigned x, unsigned& nloc, unsigned& nx) {
  const unsigned G = gridDim.x * gridDim.y * gridDim.z;
  unsigned sum, cnt, mine, sp = 0u;
  for (;;) {
    sum = 0u; cnt = 0u; mine = 0u;
#pragma unroll
    for (unsigned j = 0; j < 16; ++j) { const unsigned c = xb_ld(&bar[XB_XCNT(j)]); sum += c; cnt += (c > 0u) ? 1u : 0u; mine = (j == x) ? c : mine; }
    if (sum == G) break;
    __builtin_amdgcn_s_sleep(1);
    if ((++sp & 255u) == 0u) { if (xb_ld(&bar[XB_TMO])) break; if (sp > XB_SPIN_CAP) { atomicAdd(&bar[XB_TMO], 1u); break; } }
  }
  nloc = mine > 0u ? mine : 1u; nx = cnt > 0u ? cnt : 1u;
}
DI void xcd_barrier(const XcdBarrier& b) {
  asm volatile("s_waitcnt vmcnt(0)" ::: "memory");
  __syncthreads();
  if (threadIdx.x == 0) {
    unsigned* bar = b.bar;
    __builtin_amdgcn_s_waitcnt(0);
    unsigned nloc = b.st[0], nx = b.st[1];
    if (nloc == 0u) { xcd_barrier_complete(bar, b.x, nloc, nx); b.st[0] = nloc; b.st[1] = nx; }
    const unsigned old = xb_add(&bar[XB_XSUB(b.x)], 1u);
    const unsigned gen = old / nloc;
    if (old + 1u == (gen + 1u) * nloc) {
      __builtin_amdgcn_fence(__ATOMIC_RELEASE, "agent");
      asm volatile("s_waitcnt vmcnt(0)" ::: "memory");
      const unsigned og = xb_add(&bar[XB_TOP], 1u);
      const unsigned tg = og / nx;
      if (og + 1u == (tg + 1u) * nx) xb_add(&bar[XB_TOPGEN], 1u);
      else XB_SPIN(xb_ld(&bar[XB_TOPGEN]) == tg, bar);
      __builtin_amdgcn_fence(__ATOMIC_ACQUIRE, "agent");
      xb_add(&bar[XB_XGEN(b.x)], 1u);
      asm volatile("s_waitcnt vmcnt(0)" ::: "memory");
    } else {
      XB_SPIN(xb_ld(&bar[XB_XGEN(b.x)]) == gen, bar);
      __builtin_amdgcn_fence(__ATOMIC_ACQUIRE, "agent");
      asm volatile("s_waitcnt vmcnt(0)" ::: "memory");
    }
  }
  __syncthreads();
}

enum { EPI_BF16 = 0, EPI_VT = 1, EPI_RES = 2, EPI_SWIGLU = 3, EPI_LN = 4 };
typedef __attribute__((address_space(1))) unsigned long long gu64;
struct GemmP {
  const u16* A; const u16* B; int lda, ldb, K, Mt, Nt;
  u16* Cb; float* Cf; const float* R; int ldc;
  const float* colscale; float* aux; int aux_n0, aux_cnt; float aux_scale;
  int vt_S; int vt_bstride;
  const float* ln_g; const float* ln_b; float* outf; u16* outb; u64* stats; unsigned* cnt; unsigned* bar;
};
DI GemmP mk_gemm(const u16* A, int lda, const u16* B, int ldb, int K, int Mt, int Nt) {
  GemmP g; g.A = A; g.B = B; g.lda = lda; g.ldb = ldb; g.K = K; g.Mt = Mt; g.Nt = Nt;
  g.Cb = nullptr; g.Cf = nullptr; g.R = nullptr; g.ldc = 0; g.colscale = nullptr; g.aux = nullptr; g.aux_n0 = 1 << 30; g.aux_cnt = 0; g.aux_scale = 1.f;
  g.vt_S = 1; g.vt_bstride = 0;
  g.ln_g = nullptr; g.ln_b = nullptr; g.outf = nullptr; g.outb = nullptr; g.stats = nullptr; g.cnt = nullptr; g.bar = nullptr;
  return g;
}
constexpr int G_HT = 128 * 64;
DI int lds_byte(int r, int c) { const int st = (r >> 4) * 2 + (c >> 5), rr = r & 15, cc = c & 31, ob = rr * 64 + cc * 2; return st * 1024 + (ob ^ (((ob >> 9) & 1) << 5)); }
DI void stage_rc(int b, int& R, int& C) { const int st = b / 1024, sb = b % 1024, swz = sb ^ (((sb >> 9) & 1) << 5); R = (st >> 1) * 16 + swz / 64; C = (st & 1) * 32 + (swz % 64) / 2; }

template <int EPI>
DI void gemm_unit(const GemmP& g, int pm, int pn) {
  u16* shm = (u16*)dynsmem;
#define SA(b, h) (shm + ((b) * 2 + (h)) * G_HT)
#define SB(b, h) (shm + (4 + (b) * 2 + (h)) * G_HT)
#define GLDS(gp, lp) __builtin_amdgcn_global_load_lds((const unsigned*)(gp), (unsigned*)(lp), 16, 0, 0)
#define STAGE_A(P, br, kt) do { const u16* _g = Ab + (long)(br) * lda + (long)(kt) * 64; GLDS(_g + ao0, (char*)(P) + tid * 16); GLDS(_g + ao1, (char*)(P) + tid * 16 + 8192); } while (0)
#define STAGE_B(P, br, kt) do { const u16* _g = Bb + (long)(br) * ldb + (long)(kt) * 64; GLDS(_g + bo0, (char*)(P) + tid * 16); GLDS(_g + bo1, (char*)(P) + tid * 16 + 8192); } while (0)
#define LDA(dst, b, h) _Pragma("unroll") for (int m = 0; m < 4; ++m) _Pragma("unroll") for (int k = 0; k < 2; ++k) \
    dst[m][k] = *reinterpret_cast<const bf16x8*>((char*)SA(b, h) + lds_byte(wr * 64 + m * 16 + fr, k * 32 + fq * 8))
#define LDB(dst, b, h) _Pragma("unroll") for (int n = 0; n < 2; ++n) _Pragma("unroll") for (int k = 0; k < 2; ++k) \
    dst[n][k] = *reinterpret_cast<const bf16x8*>((char*)SB(b, h) + lds_byte(wc * 32 + n * 16 + fr, k * 32 + fq * 8))
#define MMA(ai, bj, At_, Bt_) do { __builtin_amdgcn_s_setprio(1); \
    _Pragma("unroll") for (int m = 0; m < 4; ++m) _Pragma("unroll") for (int n = 0; n < 2; ++n) _Pragma("unroll") for (int k = 0; k < 2; ++k) \
      acc[ai][bj][m][n] = __builtin_amdgcn_mfma_f32_16x16x32_bf16(Bt_[n][k], At_[m][k], acc[ai][bj][m][n], 0, 0, 0); \
    __builtin_amdgcn_s_setprio(0); } while (0)
#define WAIT_V(n) asm volatile("s_waitcnt vmcnt(" #n ")" ::: "memory")
#define WAIT_L(n) asm volatile("s_waitcnt lgkmcnt(" #n ")" ::: "memory")
#define BAR __builtin_amdgcn_s_barrier()
#define SCHED __builtin_amdgcn_sched_barrier(0)
  const int tid = TID;
  const int wid = tid >> 6, lane = tid & 63, wr = wid >> 2, wc = wid & 3, fr = lane & 15, fq = lane >> 4;
  const long lda = g.lda, ldb = g.ldb;
  const u16* Ab = g.A; const u16* Bb = g.B;
  const int brow = pm * 256, bcol = pn * 256;
  int r0_, c0_, r1_, c1_; stage_rc(tid * 16, r0_, c0_); stage_rc(tid * 16 + 8192, r1_, c1_);
  const long ao0 = (long)r0_ * lda + c0_, ao1 = (long)r1_ * lda + c1_, bo0 = (long)r0_ * ldb + c0_, bo1 = (long)r1_ * ldb + c1_;
  f32x4 acc[2][2][4][2];
#pragma unroll
  for (int a = 0; a < 2; ++a)
#pragma unroll
    for (int b = 0; b < 2; ++b)
#pragma unroll
      for (int m = 0; m < 4; ++m)
#pragma unroll
        for (int n = 0; n < 2; ++n) acc[a][b][m][n] = (f32x4){0.f, 0.f, 0.f, 0.f};
  bf16x8 At[4][2], B0[2][2], B1[2][2];
  const int nt = g.K >> 6;
  STAGE_B(SB(0, 0), bcol, 0); STAGE_A(SA(0, 0), brow, 0);
  STAGE_B(SB(0, 1), bcol + 128, 0); STAGE_A(SA(0, 1), brow + 128, 0);
  if (wr == 1) BAR;
  WAIT_V(4); BAR;
  STAGE_B(SB(1, 0), bcol, 1); STAGE_A(SA(1, 0), brow, 1); STAGE_B(SB(1, 1), bcol + 128, 1);
  WAIT_V(6); BAR;
#pragma unroll 1
  for (int t = 0; t < nt - 2; t += 2) {
    LDB(B0, 0, 0); SCHED; LDA(At, 0, 0); STAGE_A(SA(1, 1), brow + 128, t + 1);
    WAIT_L(8); BAR; WAIT_L(0); MMA(0, 0, At, B0); BAR; SCHED;
    LDB(B1, 0, 1); STAGE_B(SB(0, 0), bcol, t + 2);
    BAR; WAIT_L(0); MMA(0, 1, At, B1); BAR;
    LDA(At, 0, 1); STAGE_A(SA(0, 0), brow, t + 2);
    BAR; WAIT_L(0); MMA(1, 0, At, B0); BAR; SCHED;
    STAGE_B(SB(0, 1), bcol + 128, t + 2);
    WAIT_V(6); BAR; MMA(1, 1, At, B1); BAR;
    LDB(B0, 1, 0); SCHED; LDA(At, 1, 0); STAGE_A(SA(0, 1), brow + 128, t + 2);
    WAIT_L(8); BAR; WAIT_L(0); MMA(0, 0, At, B0); BAR; SCHED;
    LDB(B1, 1, 1); STAGE_B(SB(1, 0), bcol, t + 3);
    BAR; WAIT_L(0); MMA(0, 1, At, B1); BAR;
    LDA(At, 1, 1); STAGE_A(SA(1, 0), brow, t + 3);
    BAR; WAIT_L(0); MMA(1, 0, At, B0); BAR; SCHED;
    STAGE_B(SB(1, 1), bcol + 128, t + 3);
    WAIT_V(6); BAR; MMA(1, 1, At, B1); BAR;
  }
  { LDB(B0, 0, 0); LDA(At, 0, 0); STAGE_A(SA(1, 1), brow + 128, nt - 1);
    BAR; WAIT_L(0); MMA(0, 0, At, B0); BAR;
    LDB(B1, 0, 1); BAR; WAIT_L(0); MMA(0, 1, At, B1); BAR;
    LDA(At, 0, 1); WAIT_V(4); BAR; WAIT_L(0); MMA(1, 0, At, B0); MMA(1, 1, At, B1); BAR; }
  { LDB(B0, 1, 0); LDA(At, 1, 0); WAIT_V(2); BAR; WAIT_L(0); MMA(0, 0, At, B0); BAR;
    LDB(B1, 1, 1); WAIT_V(0); BAR; WAIT_L(0); MMA(0, 1, At, B1); BAR;
    LDA(At, 1, 1); BAR; WAIT_L(0); MMA(1, 0, At, B0); MMA(1, 1, At, B1); BAR; }
  if (wr == 0) BAR;
  const int row0 = brow + wr * 64 + fr, colb = bcol + wc * 32 + fq * 4;
  if (EPI == EPI_LN) {
    float* red = (float*)dynsmem;
    float* mr = (float*)dynsmem + 2048;
#pragma unroll
    for (int ai = 0; ai < 2; ++ai)
#pragma unroll
      for (int m = 0; m < 4; ++m) {
        const int row = row0 + ai * 128 + m * 16;
        float s1 = 0.f, s2 = 0.f;
#pragma unroll
        for (int bj = 0; bj < 2; ++bj)
#pragma unroll
          for (int n = 0; n < 2; ++n) {
            const size_t idx = (size_t)row * 2048 + colb + bj * 128 + n * 16;
            f32x4 rv;
            if (g.R) rv = *(const f32x4*)(g.R + idx);
            else { const uint2 rb = *(const uint2*)(g.outb + idx); rv[0] = bflo(rb.x); rv[1] = bfhi(rb.x); rv[2] = bflo(rb.y); rv[3] = bfhi(rb.y); }
            const f32x4 y = rv * ALPHA_ + acc[ai][bj][m][n];
            acc[ai][bj][m][n] = y;
            s1 += (y[0] + y[1]) + (y[2] + y[3]);
            s2 += (y[0] * y[0] + y[1] * y[1]) + (y[2] * y[2] + y[3] * y[3]);
          }
        s1 += shflx(s1, 16, lane); s2 += shflx(s2, 16, lane);
        s1 += shflx(s1, 32, lane); s2 += shflx(s2, 32, lane);
        if (fq == 0) { const int rl = ai * 128 + wr * 64 + m * 16 + fr; red[(rl * 4 + wc) * 2] = s1; red[(rl * 4 + wc) * 2 + 1] = s2; }
      }
    __syncthreads();
    gu64* st = (gu64*)g.stats + (size_t)pm * 8 * 256;
    if (tid < 256) {
      float a = 0.f, b = 0.f;
#pragma unroll
      for (int w = 0; w < 4; ++w) { a += red[(tid * 4 + w) * 2]; b += red[(tid * 4 + w) * 2 + 1]; }
      const u64 pk = ((u64)(__float_as_uint(b) | 0x80000000u) << 32) | (u64)__float_as_uint(a);
      __hip_atomic_store(st + pn * 256 + tid, pk, __ATOMIC_RELAXED, __HIP_MEMORY_SCOPE_AGENT);
      float sa = 0.f, sb = 0.f;
#pragma unroll 1
      for (int k = 0; k < 8; ++k) {
        u64 v = 0; unsigned sp = 0;
        for (;;) {
          v = __hip_atomic_load(st + k * 256 + tid, __ATOMIC_RELAXED, __HIP_MEMORY_SCOPE_AGENT);
          if (v >> 63) break;
          __builtin_amdgcn_s_sleep(1);
          if (++sp > XB_SPIN_CAP) break;
        }
        sa += __uint_as_float((unsigned)v); sb += __uint_as_float((unsigned)(v >> 32) & 0x7fffffffu);
      }
      const float mean = sa * (1.f / 2048.f);
      const float var = fmaxf(sb * (1.f / 2048.f) - mean * mean, 0.f);
      mr[tid * 2] = mean; mr[tid * 2 + 1] = rsqrtf(var + 1e-5f);
    }
    __syncthreads();
#pragma unroll
    for (int ai = 0; ai < 2; ++ai)
#pragma unroll
      for (int m = 0; m < 4; ++m) {
        const int rl = ai * 128 + wr * 64 + m * 16 + fr;
        const float mean = mr[rl * 2], rs = mr[rl * 2 + 1];
        const int row = row0 + ai * 128 + m * 16;
#pragma unroll
        for (int bj = 0; bj < 2; ++bj)
#pragma unroll
          for (int n = 0; n < 2; ++n) {
            const int col = colb + bj * 128 + n * 16;
            const f32x4 gg = *(const f32x4*)(g.ln_g + col), bb = *(const f32x4*)(g.ln_b + col);
            const f32x4 o = (acc[ai][bj][m][n] - mean) * rs * gg + bb;
            const size_t idx = (size_t)row * 2048 + col;
            if (g.outf) *(f32x4*)(g.outf + idx) = o;
            uint2 ob; ob.x = pk2(o[0], o[1]); ob.y = pk2(o[2], o[3]);
            *(uint2*)(g.outb + idx) = ob;
          }
      }
    __syncthreads();
  } else if (EPI == EPI_SWIGLU) {
    const int hc0 = pn * 128 + wc * 32 + fq * 4;
#pragma unroll
    for (int ai = 0; ai < 2; ++ai)
#pragma unroll
      for (int m = 0; m < 4; ++m) {
        u16* rowp = g.Cb + (size_t)(row0 + ai * 128 + m * 16) * g.ldc + hc0;
#pragma unroll
        for (int n = 0; n < 2; ++n) {
          const f32x4 gv = acc[ai][0][m][n], uv = acc[ai][1][m][n];
          float hv[4];
#pragma unroll
          for (int e = 0; e < 4; ++e) hv[e] = gv[e] * __builtin_amdgcn_rcpf(1.f + __builtin_amdgcn_exp2f(-LOG2E * gv[e])) * uv[e];
          uint2 o; o.x = pk2(hv[0], hv[1]); o.y = pk2(hv[2], hv[3]);
          *(uint2*)(rowp + n * 16) = o;
        }
      }
  } else {
#pragma unroll
    for (int ai = 0; ai < 2; ++ai)
#pragma unroll
      for (int m = 0; m < 4; ++m) {
        const int row = row0 + ai * 128 + m * 16;
#pragma unroll
        for (int bj = 0; bj < 2; ++bj)
#pragma unroll
          for (int n = 0; n < 2; ++n) {
            const int col = colb + bj * 128 + n * 16;
            f32x4 v = acc[ai][bj][m][n];
            if (EPI == EPI_BF16) {
              if (col >= g.aux_n0) {
                const int c2 = col - g.aux_n0;
                if (c2 < g.aux_cnt) *(f32x4*)(g.aux + (size_t)row * 16 + c2) = v * g.aux_scale;
              } else {
                if (g.colscale) v = v * *(const f32x4*)(g.colscale + col);
                uint2 o; o.x = pk2(v[0], v[1]); o.y = pk2(v[2], v[3]);
                *(uint2*)(g.Cb + (size_t)row * g.ldc + col) = o;
              }
            } else if (EPI == EPI_VT) {
              const int b = col / g.vt_S, sx = col - b * g.vt_S;
              uint2 o; o.x = pk2(v[0], v[1]); o.y = pk2(v[2], v[3]);
              *(uint2*)(g.Cb + (size_t)b * g.vt_bstride + (size_t)row * g.ldc + sx) = o;
            } else {
              const size_t idx = (size_t)row * g.ldc + col;
              const f32x4 rv = *(const f32x4*)(g.R + idx);
              *(f32x4*)(g.Cf + idx) = rv * ALPHA_ + v;
            }
          }
      }
  }
#undef SA
#undef SB
#undef GLDS
#undef STAGE_A
#undef STAGE_B
#undef LDA
#undef LDB
#undef MMA
}

DI bool unit_of(int L, int nM, int nN, int& pm, int& pn) {
  const int nwg = nM * nN; if (L >= nwg) return false;
  int wgid = L; { const int q = nwg / 8, r = nwg % 8, xcd = wgid % 8, off = wgid / 8; wgid = (xcd < r ? xcd * (q + 1) : r * (q + 1) + (xcd - r) * q) + off; }
  const int nig = 8 * nN, gid = wgid / nig, fm = gid * 8, gsz = (nM - fm) < 8 ? (nM - fm) : 8;
  pm = fm + ((wgid % nig) % gsz); pn = (wgid % nig) / gsz; return true;
}
DI void gemm_phase_ln(const GemmP& g) {
  const int c = BID;
  for (int r = 0; r < 2; ++r) gemm_unit<EPI_LN>(g, 32 * r + (c & 31), c >> 5);
}
template <int E1, int E2>
DI void gemm_phase2(const GemmP& g1, const GemmP& g2, char* smem) {
  const int n1 = g1.Mt * g1.Nt, n2 = g2.Mt * g2.Nt;
  for (int L = BID; L < n1 + n2; L += gridDim.x) {
    int pm, pn;
    if (L < n1) { unit_of(L, g1.Mt, g1.Nt, pm, pn); gemm_unit<E1>(g1, pm, pn); }
    else { unit_of(L - n1, g2.Mt, g2.Nt, pm, pn); gemm_unit<E2>(g2, pm, pn); }
  }
}

template <int MODE>
DI void attn_item(const u16* Qp, int ldq, const u16* Kp, int ldk, const u16* VTp, int ldv, u16* Op, int ldo,
                  int q0, int nkt, const float* Fc, const unsigned* BM, float kmaxn, char* smem) {
  const int tid = TID, lane = tid & 63, wave = tid >> 6;
  const int r = lane & 31, h = lane >> 5;
  const int qw = q0 + wave * 32, q = qw + r;
  const float c1 = 0.08838834764831845f * LOG2E;
  bf16x8 qf[8];
#pragma unroll
  for (int st = 0; st < 8; ++st) qf[st] = *(const bf16x8*)(Qp + (size_t)q * ldq + st * 16 + h * 8);
  f32x16 o[4];
#pragma unroll
  for (int i = 0; i < 4; ++i)
#pragma unroll
    for (int e = 0; e < 16; ++e) o[i][e] = 0.f;
  float m_run = -1e30f, l_run = 0.f;
  float fcq = 0.f;
  if (MODE == 1) fcq = Fc[q];
  const int krow = tid >> 4, kch = (tid & 15) ^ (krow & 15);
  const int vrow = tid >> 3, vch = (tid & 7) ^ ((tid >> 4) & 7);
  const u16* Kg0 = Kp + (size_t)krow * ldk + kch * 8; const size_t k32 = (size_t)32 * ldk;
  const u16* Vg0 = VTp + (size_t)vrow * ldv + vch * 8; const size_t v64 = (size_t)64 * ldv;
  const int pr = (r & 0x13) | ((r & 4) << 1) | ((r & 8) >> 1);
  const unsigned kro = pr * 256; const int ksw = pr & 15;
  const unsigned vro = r * 128; const int vsw = (r >> 1) & 7;
  float* fct = (float*)(smem + 131072 + 64);
  const unsigned* bmq = BM + (size_t)q * 256;
#define AT_GLDS(gp, lp) __builtin_amdgcn_global_load_lds((const unsigned*)(gp), (unsigned*)(lp), 16, 0, 0)
#define AT_TILE(it) ((MODE == 1) ? (nkt - 1 - (it)) : (it))
#define AT_STAGE(tile) do { const int _i = (tile) < nkt ? (tile) : (nkt - 1); const int _t = AT_TILE(_i); char* _s = dynsmem + ((tile) & 3) * 32768 + tid * 16; \
    const u16* _kg = Kg0 + (size_t)_t * 64 * ldk; const u16* _vg = Vg0 + _t * 64; \
    AT_GLDS(_kg, _s); AT_GLDS(_kg + k32, _s + 8192); AT_GLDS(_vg, _s + 16384); AT_GLDS(_vg + v64, _s + 16384 + 8192); } while (0)
  f32x4 rf = {0.f, 0.f, 0.f, 0.f};
  uint2 bw = make_uint2(0xffffffffu, 0xffffffffu);
  if (MODE == 1) rf = *(const f32x4*)(Fc + AT_TILE(0) * 64 + (tid & 15) * 4);
  if (MODE == 2) bw = *(const uint2*)(bmq);
  float qkb = 0.f;
  if (MODE == 1) {
    float qs = 0.f;
#pragma unroll
    for (int st = 0; st < 8; ++st)
#pragma unroll
      for (int e = 0; e < 8; ++e) { const float v = bf2f((u16)qf[st][e]); qs += v * v; }
    qs += shflx(qs, 32, lane);
    qkb = sqrtf(qs) * kmaxn * c1 * 1.01f + fcq;
  }
  int* votes = (int*)(smem + 131072 + 64 + 1024);
  AT_STAGE(0); AT_STAGE(1); AT_STAGE(2);
  if (MODE == 1 && tid < 16) *(f32x4*)(fct + tid * 4) = rf;
  asm volatile("s_waitcnt vmcnt(0)" ::: "memory");
  __syncthreads();
  f32x16 sc[2];
#pragma unroll
  for (int k2 = 0; k2 < 2; ++k2) {
#pragma unroll
    for (int e = 0; e < 16; ++e) sc[k2][e] = 0.f;
#pragma unroll
    for (int st = 0; st < 8; ++st) {
      bf16x8 a = *(const bf16x8*)(smem + kro + k2 * 8192 + (((st * 2 + h) ^ ksw) << 4));
      sc[k2] = MFMA(a, qf[st], sc[k2]);
    }
  }
#pragma unroll 1
  for (int kt = 0; kt < nkt; ++kt) {
    const char* sKn = smem + ((kt + 1) & 3) * 32768;
    const char* sV = smem + (kt & 3) * 32768 + 16384;
    const float* sF = fct + (kt & 3) * 64;
    const int ts = AT_TILE(kt) * 64;
    const bool more1 = (kt + 1 < nkt);
    uint2 bwn = make_uint2(0xffffffffu, 0xffffffffu);
    const int tn = AT_TILE(more1 ? (kt + 1) : kt);
    float flast = 0.f;
    if (MODE == 1) { rf = *(const f32x4*)(Fc + tn * 64 + (tid & 15) * 4); flast = Fc[tn * 64 + 63]; }
    if (MODE == 2) bwn = *(const uint2*)(bmq + tn * 2);
    AT_STAGE(kt + 3);
    const bool diag = (MODE == 1) && (ts + 63 > qw);
    float mx = -1e30f;
    if (MODE == 1) {
#pragma unroll
      for (int k2 = 0; k2 < 2; ++k2)
#pragma unroll
        for (int j = 0; j < 4; ++j) {
          const int kl = 32 * k2 + 16 * (j >> 1) + 8 * h + 4 * (j & 1);
          const f32x4 f4 = *(const f32x4*)(sF + kl);
#pragma unroll
          for (int i = 0; i < 4; ++i) {
            float x = sc[k2][j * 4 + i] * c1 + (fcq - f4[i]);
            if (diag && (ts + kl + i > q)) x = -1e30f;
            sc[k2][j * 4 + i] = x;
            mx = fmaxf(mx, x);
          }
        }
    } else {
#pragma unroll
      for (int k2 = 0; k2 < 2; ++k2)
#pragma unroll
        for (int e = 0; e < 16; ++e) mx = fmaxf(mx, sc[k2][e]);
      mx *= c1;
    }
    mx = fmaxf(mx, shflx(mx, 32, lane));
    if (__any(mx > m_run + 8.f)) {
      const float m_new = fmaxf(m_run, mx);
      const float alpha = __builtin_amdgcn_exp2f(m_run - m_new);
      m_run = m_new; l_run *= alpha;
#pragma unroll
      for (int i = 0; i < 4; ++i)
#pragma unroll
        for (int e = 0; e < 16; ++e) o[i][e] *= alpha;
    }
    f32x16 sn[2];
    float ps = 0.f;
#pragma unroll
    for (int g4 = 0; g4 < 4; ++g4) {
      const int k2 = g4 >> 1, s2 = g4 & 1;
      const f32x16 zero16 = {0.f, 0.f, 0.f, 0.f, 0.f, 0.f, 0.f, 0.f, 0.f, 0.f, 0.f, 0.f, 0.f, 0.f, 0.f, 0.f};
#pragma unroll
      for (int st = s2 * 4; st < s2 * 4 + 4; ++st) {
        bf16x8 a = *(const bf16x8*)(sKn + kro + k2 * 8192 + (((st * 2 + h) ^ ksw) << 4));
        sn[k2] = (st == 0) ? MFMA(a, qf[st], zero16) : MFMA(a, qf[st], sn[k2]);
      }
      const unsigned wbits = k2 ? bw.y : bw.x;
      float pv8[8];
#pragma unroll
      for (int e8 = 0; e8 < 8; ++e8) {
        const int e = 8 * s2 + e8;
        float pv;
        if (MODE == 1) {
          const float x = sc[k2][e];
          pv = __builtin_amdgcn_exp2f(x - m_run);
          if (diag) pv = (x <= -1e29f) ? 0.f : pv;
        } else {
          pv = __builtin_amdgcn_exp2f(sc[k2][e] * c1 - m_run);
          if (MODE == 2) {
            const int kb = 16 * ((e >> 2) >> 1) + 8 * h + 4 * ((e >> 2) & 1) + (e & 3);
            const int msk = __builtin_amdgcn_sbfe(wbits, kb, 1);
            pv = __int_as_float(__float_as_int(pv) & msk);
          }
        }
        pv8[e8] = pv; ps += pv;
      }
      u32x4 u;
      u[0] = pk2(pv8[0], pv8[1]); u[1] = pk2(pv8[2], pv8[3]); u[2] = pk2(pv8[4], pv8[5]); u[3] = pk2(pv8[6], pv8[7]);
      const bf16x8 pfg = __builtin_bit_cast(bf16x8, u);
#pragma unroll
      for (int dt = 0; dt < 4; ++dt) {
        bf16x8 a = *(const bf16x8*)(sV + vro + dt * 4096 + (((4 * k2 + 2 * s2 + h) ^ vsw) << 4));
        o[dt] = MFMA(a, pfg, o[dt]);
      }
      __builtin_amdgcn_sched_barrier(0);
    }
    l_run += ps;
    asm volatile("s_waitcnt vmcnt(4)" ::: "memory");
    if (MODE == 1 && tid < 16) *(f32x4*)(fct + ((kt + 1) & 3) * 64 + tid * 4) = rf;
    if (MODE == 1) {
      const int v = __all((qkb - flast) < (m_run - 160.f)) ? 1 : 0;
      if (lane == 0) votes[(kt & 1) * 8 + wave] = v;
    }
    asm volatile("s_waitcnt lgkmcnt(0)" ::: "memory");
    __builtin_amdgcn_s_barrier();
    asm volatile("" ::: "memory");
    sc[0] = sn[0]; sc[1] = sn[1]; bw = bwn;
    if (MODE == 1) {
      const int* vp = votes + (kt & 1) * 8;
      const int all8 = vp[0] & vp[1] & vp[2] & vp[3] & vp[4] & vp[5] & vp[6] & vp[7];
      if (all8) break;
    }
  }
  asm volatile("s_waitcnt vmcnt(0)" ::: "memory");
  __syncthreads();
#undef AT_STAGE
#undef AT_TILE
#undef AT_GLDS
  const float l = l_run + shflx(l_run, 32, lane);
  const float inv = 1.f / l;
  u16* orow = Op + (size_t)q * ldo;
#pragma unroll
  for (int dt = 0; dt < 4; ++dt)
#pragma unroll
    for (int j = 0; j < 4; ++j) {
      uint2 u; u.x = pk2(o[dt][j * 4 + 0] * inv, o[dt][j * 4 + 1] * inv); u.y = pk2(o[dt][j * 4 + 2] * inv, o[dt][j * 4 + 3] * inv);
      *(uint2*)(orow + 32 * dt + 8 * j + 4 * h) = u;
    }
}

template <int MODE>
DI void self_attn_phase(const Params& p, int qcol, int kcol, int j, char* smem) {
  const u16* H = (const u16*)(p.ws + O_H); const u16* VT = (const u16*)(p.ws + O_VT); u16* CAT = (u16*)(p.ws + O_CAT);
  const float* FC = (const float*)(p.ws + O_FC); const unsigned* BM = (const unsigned*)(p.ws + O_BM);
  for (int idx = BID; idx < 512; idx += gridDim.x) {
    const int bh = idx & 15, qi = idx >> 4;
    const int qb = (qi < 16) ? (31 - qi) : (qi - 16);
    const int b = bh >> 3, hd = bh & 7;
    const int q0 = qb * 256, nkt = 4 * (qb + 1);
    attn_item<MODE>(H + (size_t)b * S_ * HLD + qcol + hd * 128, HLD, H + (size_t)b * S_ * HLD + kcol + hd * 128, HLD,
                    VT + ((size_t)b * 1024 + hd * 128) * S_, S_, CAT + (size_t)b * S_ * DM + 1024 + hd * 128, DM,
                    q0, nkt, FC + (size_t)(b * 8 + hd) * S_, BM + (size_t)b * S_ * 256,
                    (MODE == 1) ? sqrtf(__uint_as_float(((const unsigned*)(p.ws + O_BAR))[KN_WORD0 + j * 8 + hd])) : 0.f, smem);
  }
}
DI void cross_attn_phase(const Params& p, int layer, char* smem) {
  const u16* CQ = (const u16*)(p.ws + O_CQ); u16* CO = (u16*)(p.ws + O_CO);
  const u16* MK = (const u16*)(p.ws + O_MEMK) + (size_t)layer * 512 * 512;
  const u16* MVT = (const u16*)(p.ws + O_MEMVT) + (size_t)layer * 512 * 512;
  for (int idx = BID; idx < 256; idx += gridDim.x) {
    const int bh = idx & 7, qb = idx >> 3, b = bh >> 2, hd = bh & 3;
    attn_item<0>(CQ + (size_t)b * S_ * 512 + hd * 128, 512, MK + (size_t)b * 256 * 512 + hd * 128, 512,
                 MVT + ((size_t)b * 512 + hd * 128) * 256, 256, CO + (size_t)b * S_ * 512 + hd * 128, 512,
                 qb * 256, 4, nullptr, nullptr, 0.f, smem);
  }
}

DI void score_phase(const Params& p, char* smem) {
  const u16* H = (const u16*)(p.ws + O_H); const float* AUX = (const float*)(p.ws + O_AUX); float* SC = (float*)(p.ws + O_SC);
  const int tid = TID, lane = tid & 63, wave = tid >> 6, r = lane & 31, h = lane >> 5;
  float* wl = (float*)smem + wave * 128;
  for (int idx = BID; idx < 512; idx += gridDim.x) {
    const int half = idx & 1, b = (idx >> 1) & 1, t = idx >> 2;
    const int blk = (t < 64) ? (127 - t) : (t - 64);
    const int n = (blk + 1) * 64, ntile = n >> 5;
    const int nt_lo = half ? (ntile >> 1) : 0, nt_hi = half ? ntile : (ntile >> 1);
    const int t0 = blk * 64 + wave * 8;
    const u16* Hb = H + (size_t)b * S_ * HLD;
    bf16x8 af[4][4];
#pragma unroll
    for (int rt = 0; rt < 4; ++rt) {
      const int tokA = t0 + 2 * rt + ((r >> 2) & 1), head = (r >> 3) * 4 + (r & 3);
#pragma unroll
      for (int st = 0; st < 4; ++st) af[rt][st] = *(const bf16x8*)(Hb + (size_t)tokA * HLD + 3072 + head * 64 + st * 16 + 8 * h);
    }
    wl[lane] = AUX[(size_t)(b * S_ + t0) * 16 + lane] * 0.125f;
    wl[64 + lane] = AUX[(size_t)(b * S_ + t0) * 16 + 64 + lane] * 0.125f;
    __syncthreads();
    float* scb = SC + (size_t)b * SCB + (size_t)2048 * blk * (blk + 1);
    bf16x8 bfr[4], bnx[4];
#pragma unroll
    for (int st = 0; st < 4; ++st) bfr[st] = *(const bf16x8*)(Hb + (size_t)(nt_lo * 32 + r) * HLD + 4096 + st * 16 + 8 * h);
#pragma unroll 1
    for (int nt2 = nt_lo; nt2 < nt_hi; ++nt2) {
      const int k0 = nt2 * 32;
      const int kn = (nt2 + 1 < nt_hi) ? (k0 + 32) : k0;
#pragma unroll
      for (int st = 0; st < 4; ++st) bnx[st] = *(const bf16x8*)(Hb + (size_t)(kn + r) * HLD + 4096 + st * 16 + 8 * h);
#pragma unroll
      for (int rt = 0; rt < 4; ++rt) {
        f32x16 acc;
#pragma unroll
        for (int e = 0; e < 16; ++e) acc[e] = 0.f;
#pragma unroll
        for (int st = 0; st < 4; ++st) acc = MFMA(af[rt][st], bfr[st], acc);
        float s = 0.f;
#pragma unroll
        for (int e4 = 0; e4 < 4; ++e4) {
          const f32x4 wv = *(const f32x4*)(wl + (2 * rt + h) * 16 + e4 * 4);
#pragma unroll
          for (int i = 0; i < 4; ++i) s += fmaxf(acc[e4 * 4 + i], 0.f) * wv[i];
        }
        const int row = (t0 + 2 * rt + h) - blk * 64;
        __builtin_nontemporal_store(s, scb + (size_t)row * n + k0 + r);
      }
#pragma unroll
      for (int st = 0; st < 4; ++st) bfr[st] = bnx[st];
    }
    __syncthreads();
  }
}

DI int wave_sum_i(int v, int lane) {
#pragma unroll
  for (int o = 32; o > 0; o >>= 1) v += shflxi(v, o, lane);
  return v;
}
template <int NJ>
DI void select_row(const float* row, int n, u64* bmrow, int lane) {
  unsigned key[NJ];
#pragma unroll
  for (int jj = 0; jj < NJ; ++jj) {
    const int idx = jj * 64 + lane;
    unsigned k = 0;
    if (idx < n) { unsigned u = __float_as_uint(__builtin_nontemporal_load(row + idx)); k = (u & 0x80000000u) ? ~u : (u | 0x80000000u); }
    key[jj] = k;
  }
  unsigned km = 0;
#pragma unroll
  for (int jj = 0; jj < NJ; ++jj) km = (key[jj] > km) ? key[jj] : km;
#pragma unroll
  for (int o = 32; o > 0; o >>= 1) { const unsigned t = (unsigned)shflxi((int)km, o, lane); km = (t > km) ? t : km; }
  unsigned lo = 0, hi = (km == 0xffffffffu) ? km : (km + 1u), T = 0;
  bool exact = false;
  {
    unsigned cand = km & 0xff800000u;
#pragma unroll 1
    for (int pr = 0; pr < 4; ++pr) {
      if (cand <= lo || cand >= hi) break;
      int c = 0;
#pragma unroll
      for (int jj = 0; jj < NJ; ++jj)
        asm volatile("v_cmp_le_u32 vcc, %1, %2\n\tv_addc_co_u32 %0, vcc, 0, %0, vcc" : "+v"(c) : "s"(cand), "v"(key[jj]) : "vcc");
      c = wave_sum_i(c, lane);
      if (c == 256) { T = cand; exact = true; break; }
      if (c > 256) { lo = cand; break; }
      hi = cand;
      if (cand < 0x00800000u) break;
      cand -= 0x00800000u;
    }
  }
#pragma unroll 1
  while (!exact && hi - lo > 1u) {
    const unsigned cand = lo + ((hi - lo) >> 1);
    int c = 0;
#pragma unroll
    for (int jj = 0; jj < NJ; ++jj)
      asm volatile("v_cmp_le_u32 vcc, %1, %2\n\tv_addc_co_u32 %0, vcc, 0, %0, vcc" : "+v"(c) : "s"(cand), "v"(key[jj]) : "vcc");
    c = wave_sum_i(c, lane);
    if (c == 256) { T = cand; exact = true; }
    else if (c > 256) lo = cand; else hi = cand;
  }
  if (!exact) T = lo;
  unsigned X = 0xffffffffu;
  if (!exact) {
    int cgt = 0, ceq = 0;
#pragma unroll
    for (int jj = 0; jj < NJ; ++jj) {
      asm volatile("v_cmp_lt_u32 vcc, %1, %2\n\tv_addc_co_u32 %0, vcc, 0, %0, vcc" : "+v"(cgt) : "s"(T), "v"(key[jj]) : "vcc");
      asm volatile("v_cmp_eq_u32 vcc, %1, %2\n\tv_addc_co_u32 %0, vcc, 0, %0, vcc" : "+v"(ceq) : "s"(T), "v"(key[jj]) : "vcc");
    }
    cgt = wave_sum_i(cgt, lane); ceq = wave_sum_i(ceq, lane);
    const int need = 256 - cgt;
    unsigned bigv = 0x7fffffffu;
    asm volatile("" : "+v"(bigv));
    if (ceq != need) {
      X = 0;
#pragma unroll 1
      for (int bit = 13; bit >= 0; --bit) {
        const unsigned cand = X | (1u << bit);
        int c = 0;
#pragma unroll
        for (int jj = 0; jj < NJ; ++jj) {
          unsigned tmp;
          asm volatile("v_add_u32 %1, %7, %5\n\tv_cmp_eq_u32 vcc, %2, %3\n\tv_cndmask_b32 %1, %4, %1, vcc\n\tv_cmp_gt_u32 vcc, %6, %1\n\tv_addc_co_u32 %0, vcc, 0, %0, vcc"
                       : "+v"(c), "=&v"(tmp) : "s"(T), "v"(key[jj]), "v"(bigv), "v"(lane), "s"(cand), "n"(jj * 64) : "vcc");
        }
        c = wave_sum_i(c, lane);
        if (c <= need) X = cand;
      }
    }
  }
  unsigned kl0 = 0, kh0 = 0, kl1 = 0, kh1 = 0;
  unsigned T1v = T + 1, Tv = T;
  asm volatile("" : "+v"(Tv), "+v"(T1v));
#pragma unroll
  for (int jj = 0; jj < NJ; ++jj) {
    unsigned tmp;
    if (jj < 64)
      asm volatile("v_add_u32 %2, %9, %4\n\tv_cmp_gt_u32 vcc, %3, %2\n\tv_cndmask_b32 %2, %5, %6, vcc\n\tv_cmp_ge_u32 vcc, %7, %2\n\ts_nop 3\n\tv_writelane_b32 %0, vcc_lo, %8\n\tv_writelane_b32 %1, vcc_hi, %8"
                   : "+v"(kl0), "+v"(kh0), "=&v"(tmp) : "s"(X), "v"(lane), "v"(T1v), "v"(Tv), "v"(key[jj]), "n"(jj & 63), "n"(jj * 64) : "vcc");
    else
      asm volatile("v_add_u32 %2, %9, %4\n\tv_cmp_gt_u32 vcc, %3, %2\n\tv_cndmask_b32 %2, %5, %6, vcc\n\tv_cmp_ge_u32 vcc, %7, %2\n\ts_nop 3\n\tv_writelane_b32 %0, vcc_lo, %8\n\tv_writelane_b32 %1, vcc_hi, %8"
                   : "+v"(kl1), "+v"(kh1), "=&v"(tmp) : "s"(X), "v"(lane), "v"(T1v), "v"(Tv), "v"(key[jj]), "n"(jj & 63), "n"(jj * 64) : "vcc");
  }
  bmrow[lane] = ((u64)kh0 << 32) | kl0; bmrow[64 + lane] = ((u64)kh1 << 32) | kl1;
}
DI void select_phase(const Params& p) {
  const float* SC = (const float*)(p.ws + O_SC); u64* BM = (u64*)(p.ws + O_BM);
  const int tid_ = TID; const int lane = tid_ & 63, wave = tid_ >> 6;
  const int nw = gridDim.x * NWAVE, gw = BID * NWAVE + wave;
  int it = 0;
  for (int base = 0; base < NTOK; base += nw, ++it) {
    const int rowi = base + ((it & 1) ? (nw - 1 - gw) : gw);
    if (rowi >= NTOK) continue;
    const int b = rowi >> 13, t = rowi & 8191, blk = t >> 6, rr = t & 63, n = (blk + 1) * 64;
    const float* row = SC + (size_t)b * SCB + (size_t)2048 * blk * (blk + 1) + (size_t)rr * n;
    u64* bmrow = BM + (size_t)rowi * 128;
    if (n <= 256) {
      const int nwd = n >> 6;
      bmrow[lane] = (lane < nwd) ? ~0ull : 0ull; bmrow[64 + lane] = 0ull;
    } else if (n <= 2048) select_row<32>(row, n, bmrow, lane);
    else if (n <= 4096) select_row<64>(row, n, bmrow, lane);
    else select_row<128>(row, n, bmrow, lane);
  }
}

DI void prep_even(const Params& p, int j, char* smem) {
  u16* H = (u16*)(p.ws + O_H); u16* DP = (u16*)(p.ws + O_DP);
  const int tid5 = TID, tid = tid5 & 255;
  const int gs = gridDim.x * 2;
  constexpr int NB = 4;
  const int which = tid >> 7, tt = tid & 127;
  const int offA = 1024 + which * 1024 + (tt >> 4) * 128 + (tt & 15);
  const int fiA = tt & 15;
  const bool hasB = tid < 136;
  const int offB = (tid < 128) ? (3072 + (tid >> 3) * 64 + (tid & 7)) : (4096 + (tid - 128));
  const int fiB = 16 + ((tid < 128) ? (tid & 7) : ((tid - 128) & 7));
  const int c0 = tid * 4, g = c0 >> 8, w = 2 << g;
  for (int tok0 = BID * 2 + (tid5 >> 8); tok0 < NTOK; tok0 += gs * NB) {
    float pos[NB], a1[NB], a2[NB], b1[NB], b2[NB];
#pragma unroll
    for (int u = 0; u < NB; ++u) {
      const int tok = tok0 + u * gs; const bool ok = tok < NTOK;
      const u16* hr = H + (size_t)(ok ? tok : 0) * HLD;
      pos[u] = (float)p.pos[ok ? tok : 0];
      a1[u] = bf2f(hr[offA]); a2[u] = bf2f(hr[offA + 16]);
      b1[u] = hasB ? bf2f(hr[offB]) : 0.f; b2[u] = hasB ? bf2f(hr[offB + 8]) : 0.f;
    }
    {
      float* csl = (float*)smem;
      __syncthreads();
      if (tid5 < 2 * NB * 24) {
        const int hf = tid5 / (NB * 24), rem = tid5 - hf * (NB * 24), uu2 = rem / 24, f = rem - uu2 * 24;
        int tk = (tok0 - (tid5 >> 8)) + hf + uu2 * gs; tk = tk < NTOK ? tk : 0;
        const float ang = (float)p.pos[tk] * (f < 16 ? c_invf32[f] : c_invf16[f - 16]);
        csl[tid5 * 2] = cosf(ang); csl[tid5 * 2 + 1] = sinf(ang);
      }
      __syncthreads();
    }
#pragma unroll
    for (int u = 0; u < NB; ++u) {
      const int tok = tok0 + u * gs;
      if (tok < NTOK) {
        const u16* hr = H + (size_t)tok * HLD;
        const int t = tok & (S_ - 1);
        const int cnt = (t + 1 < w) ? (t + 1) : w;
        float s0 = 0.f, s1 = 0.f, s2 = 0.f, s3 = 0.f;
        for (int i = 0; i < cnt; ++i) {
          const uint2 v = *(const uint2*)(hr - (size_t)i * HLD + c0);
          s0 += bflo(v.x); s1 += bfhi(v.x); s2 += bflo(v.y); s3 += bfhi(v.y);
        }
        const uint2 uu = *(const uint2*)(hr + c0);
        const float ic = 1.f / (float)cnt;
        uint2 o; o.x = pk2(s0 * ic - bflo(uu.x), s1 * ic - bfhi(uu.x)); o.y = pk2(s2 * ic - bflo(uu.y), s3 * ic - bfhi(uu.y));
        *(uint2*)(DP + (size_t)tok * 1024 + c0) = o;
      }
    }
#pragma unroll
    for (int u = 0; u < NB; ++u) {
      const int tok = tok0 + u * gs;
      if (tok < NTOK) {
        u16* hr = H + (size_t)tok * HLD;
        const float* cst = (const float*)smem + (((tid5 >> 8) * NB + u) * 24) * 2;
        {
          const float cs = cst[fiA * 2], sn = cst[fiA * 2 + 1];
          hr[offA] = f2bf(a1[u] * cs - a2[u] * sn); hr[offA + 16] = f2bf(a2[u] * cs + a1[u] * sn);
        }
        if (hasB) {
          const float cs = cst[fiB * 2], sn = cst[fiB * 2 + 1];
          hr[offB] = f2bf(b1[u] * cs - b2[u] * sn); hr[offB + 8] = f2bf(b2[u] * cs + b1[u] * sn);
        }
      }
    }
  }
}

DI void prep_odd(const Params& p, int j, char* smem) {
  const u16* H = (const u16*)(p.ws + O_H); u16* CAT = (u16*)(p.ws + O_CAT);
  const float* AUX = (const float*)(p.ws + O_AUX); float* FC = (float*)(p.ws + O_FC);
  const int tid5 = TID, tid = tid5 & 255;
  for (int seq = BID; seq < 16; seq += gridDim.x) {
    const int b = seq >> 3, hd = seq & 7;
    const float fb = p.od_forget_b[j * 8 + hd];
    float* part = (float*)smem;
    float loc[16]; float run = 0.f;
#pragma unroll
    for (int i = 0; i < 16; ++i) {
      const float xv = AUX[(size_t)(b * S_ + tid5 * 16 + i) * 16 + hd] + fb;
      const float lf = fminf(xv, 0.f) - log1pf(__expf(-fabsf(xv)));
      run += lf; loc[i] = run;
    }
    part[tid5] = run;
    __syncthreads();
    float off = 0.f;
    for (int i = 0; i < tid5; ++i) off += part[i];
#pragma unroll
    for (int i = 0; i < 16; ++i) FC[(size_t)seq * S_ + tid5 * 16 + i] = (off + loc[i]) * LOG2E;
    __syncthreads();
  }
  const float* cw = p.od_conv_w + (size_t)j * 3 * 1024;
  const int c0 = tid * 4;
  const f32x4 w0 = *(const f32x4*)(cw + c0), w1 = *(const f32x4*)(cw + 1024 + c0), w2 = *(const f32x4*)(cw + 2048 + c0);
  float knmax = 0.f; const int lane_ = tid5 & 63;
  const int gs = gridDim.x * 2;
  constexpr int NB = 4;
  for (int tok0 = BID * 2 + (tid5 >> 8); tok0 < NTOK; tok0 += gs * NB) {
    uint2 uu[NB][3], gc[NB][3], gb[NB], kk[NB];
#pragma unroll
    for (int u = 0; u < NB; ++u) {
      const int tok = tok0 + u * gs; const bool ok = tok < NTOK;
      const int t = tok & (S_ - 1);
      const u16* hr = H + (size_t)(ok ? tok : 0) * HLD;
#pragma unroll
      for (int k = 0; k < 3; ++k) {
        const int back = 2 - k;
        const bool v = ok && (t - back >= 0);
        const u16* hp = hr - (size_t)(v ? back : 0) * HLD;
        uu[u][k] = *(const uint2*)(hp + c0); gc[u][k] = *(const uint2*)(hp + 2048 + c0);
        if (!v) { uu[u][k] = make_uint2(0u, 0u); gc[u][k] = make_uint2(0u, 0u); }
      }
      gb[u] = *(const uint2*)(hr + 1024 + c0);
      kk[u] = *(const uint2*)(hr + 4096 + c0);
      if (!ok) kk[u] = make_uint2(0u, 0u);
    }
#pragma unroll
    for (int u = 0; u < NB; ++u) {
      const int tok = tok0 + u * gs;
      {
        float ks = bflo(kk[u].x) * bflo(kk[u].x) + bfhi(kk[u].x) * bfhi(kk[u].x) + bflo(kk[u].y) * bflo(kk[u].y) + bfhi(kk[u].y) * bfhi(kk[u].y);
#pragma unroll
        for (int o = 16; o > 0; o >>= 1) ks += shflx(ks, o, lane_);
        knmax = fmaxf(knmax, ks);
      }
      float a0 = 0.f, a1 = 0.f, a2 = 0.f, a3 = 0.f;
#pragma unroll
      for (int k = 0; k < 3; ++k) {
        const f32x4 ww = (k == 0) ? w0 : (k == 1) ? w1 : w2;
        a0 += ww[0] * bflo(uu[u][k].x) * bflo(gc[u][k].x); a1 += ww[1] * bfhi(uu[u][k].x) * bfhi(gc[u][k].x);
        a2 += ww[2] * bflo(uu[u][k].y) * bflo(gc[u][k].y); a3 += ww[3] * bfhi(uu[u][k].y) * bfhi(gc[u][k].y);
      }
      if (tok < NTOK) {
        uint2 o; o.x = pk2(a0 * bflo(gb[u].x), a1 * bfhi(gb[u].x)); o.y = pk2(a2 * bflo(gb[u].y), a3 * bfhi(gb[u].y));
        *(uint2*)(CAT + (size_t)tok * DM + c0) = o;
      }
    }
  }
  if ((lane_ & 31) == 0) atomicMax((unsigned*)(p.ws + O_BAR) + KN_WORD0 + j * 8 + (tid >> 5), __float_as_uint(knmax));
}

DI void ln_phase(const Params& p, const float* g, const float* bta, float* outf) {
  const float* Y = (const float*)(p.ws + O_Y); u16* XB = (u16*)(p.ws + O_XB);
  const int tid_ = TID; const int lane = tid_ & 63, wave = tid_ >> 6;
  const int nw = gridDim.x * NWAVE, gw = BID * NWAVE + wave;
  for (int row = gw; row < NTOK; row += nw) {
    const float* yr = Y + (size_t)row * DM;
    float4 v[8]; float s = 0.f;
#pragma unroll
    for (int i = 0; i < 8; ++i) { v[i] = *(const float4*)(yr + (i * 64 + lane) * 4); s += v[i].x + v[i].y + v[i].z + v[i].w; }
#pragma unroll
    for (int o = 32; o > 0; o >>= 1) s += shflx(s, o, lane);
    const float mu = s * (1.f / DM);
    float q = 0.f;
#pragma unroll
    for (int i = 0; i < 8; ++i) { float a = v[i].x - mu, b = v[i].y - mu, c = v[i].z - mu, d = v[i].w - mu; q += a * a + b * b + c * c + d * d; }
#pragma unroll
    for (int o = 32; o > 0; o >>= 1) q += shflx(q, o, lane);
    const float rs = rsqrtf(q * (1.f / DM) + 1e-5f);
#pragma unroll
    for (int i = 0; i < 8; ++i) {
      const int c = (i * 64 + lane) * 4;
      const float4 gg = *(const float4*)(g + c), bb = *(const float4*)(bta + c);
      float4 o4;
      o4.x = (v[i].x - mu) * rs * gg.x + bb.x; o4.y = (v[i].y - mu) * rs * gg.y + bb.y;
      o4.z = (v[i].z - mu) * rs * gg.z + bb.z; o4.w = (v[i].w - mu) * rs * gg.w + bb.w;
      *(float4*)(outf + (size_t)row * DM + c) = o4;
      uint2 ob; ob.x = pk2(o4.x, o4.y); ob.y = pk2(o4.z, o4.w);
      *(uint2*)(XB + (size_t)row * DM + c) = ob;
    }
  }
}


constexpr int PH_PER_LAYER = 14;
constexpr int N_PHASES = 1 + 4 * PH_PER_LAYER;

DI void run_phase(const Params& p, int ph, char* smem) {
  char* ws = p.ws;
  const u16* XB = (const u16*)(ws + O_XB);
  float* XF = (float*)(ws + O_XF);
  if (ph == 0) { convert_phase(p, smem); return; }
  const int L = (ph - 1) / PH_PER_LAYER, sp = (ph - 1) % PH_PER_LAYER;
  const int j = L >> 1; const bool even = (L & 1) == 0;
  const float* resid = (L == 0) ? p.x : nullptr;
  const GemmP gz = mk_gemm(nullptr, 0, nullptr, 0, 0, 0, 0);
  switch (sp) {
    case 0: {
      GemmP g1 = mk_gemm(XB, DM, (const u16*)(ws + (even ? O_EVIN + j * SZ_EVIN : O_ODIN + j * SZ_ODIN)), DM, DM, 64, even ? EV_N / 256 : OD_N / 256);
      g1.Cb = (u16*)(ws + O_H); g1.ldc = HLD; g1.aux = (float*)(ws + O_AUX);
      if (even) { g1.aux_n0 = 4160; g1.aux_cnt = 16; g1.aux_scale = 0.25f; } else { g1.aux_n0 = 5120; g1.aux_cnt = 8; g1.aux_scale = 1.f; }
      GemmP g2 = mk_gemm((const u16*)(ws + (even ? O_EVV : O_ODV) + j * SZ_V), DM, XB, DM, DM, 4, 64);
      g2.Cb = (u16*)(ws + O_VT); g2.ldc = S_; g2.vt_S = S_; g2.vt_bstride = 1024 * S_;
      {
        const int n1 = g1.Mt * g1.Nt, n2 = g2.Mt * g2.Nt, nm = (L == 0) ? 32 : 0, G = gridDim.x;
        bool pre = false;
        for (int U = BID; U < n1 + n2 + nm; U += G) {
          int pm, pn, pm2 = 0, pn2 = 0;
          const int Un = U + G;
          if (U < n1) {
            unit_of(U, g1.Mt, g1.Nt, pm, pn);
            gemm_unit<EPI_BF16>(g1, pm, pn);
          } else if (U < n1 + n2) {
            unit_of(U - n1, g2.Mt, g2.Nt, pm, pn);
            gemm_unit<EPI_VT>(g2, pm, pn);
          } else {
            const int t = U - n1 - n2;
            const int layer = t >> 3, kind = (t >> 2) & 1, m = (t >> 1) & 1, n = t & 1;
            const u16* MB = (const u16*)(ws + O_MEMB);
            if (kind == 0) {
              GemmP g = mk_gemm(MB, DM, (const u16*)(ws + O_CAK + layer * SZ_CA), DM, DM, 2, 2);
              g.Cb = (u16*)(ws + O_MEMK) + (size_t)layer * 512 * 512; g.ldc = 512;
              gemm_unit<EPI_BF16>(g, m, n);
            } else {
              GemmP g = mk_gemm((const u16*)(ws + O_CAV + layer * SZ_CA), DM, MB, DM, DM, 2, 2);
              g.Cb = (u16*)(ws + O_MEMVT) + (size_t)layer * 512 * 512; g.ldc = 256; g.vt_S = 256; g.vt_bstride = 512 * 256;
              gemm_unit<EPI_VT>(g, m, n);
            }
          }
          (void)pre; (void)pm2; (void)pn2; (void)Un;
        }
      }
    } break;
    case 1: if (even) prep_even(p, j, smem); else prep_odd(p, j, smem); break;
    case 2: if (even) {
      score_phase(p, smem);
      for (int t = BID; t < 4 * 64; t += gridDim.x) {
        const int m = t & 63, grp = t >> 6;
        GemmP g = mk_gemm((const u16*)(ws + O_DP) + grp * 256, 1024, (const u16*)(ws + O_POOL) + (size_t)(j * 4 + grp) * 256 * 256, 256, 256, 64, 1);
        g.Cb = (u16*)(ws + O_CAT) + grp * 256; g.ldc = DM; g.colscale = p.ev_pool_scale + j * 1024 + grp * 256;
        gemm_unit<EPI_BF16>(g, m, 0);
      }
    } break;
    case 3: if (even) select_phase(p); break;
    case 4: if (even) self_attn_phase<2>(p, 1024, 2048, j, smem); else self_attn_phase<1>(p, 3072, 4096, j, smem); break;
    case 5: {
      GemmP g1 = mk_gemm((const u16*)(ws + O_CAT), DM, (const u16*)(ws + (even ? O_EVOUT : O_ODOUT) + j * SZ_SQ), DM, DM, 64, 8);
      g1.R = resid; g1.ln_g = p.ln_g + (size_t)(L * 3 + 0) * DM; g1.ln_b = p.ln_b + (size_t)(L * 3 + 0) * DM;
      g1.outf = nullptr; g1.outb = (u16*)(ws + O_XB); g1.stats = (u64*)(ws + O_STATS) + (size_t)(L * 3 + 0) * 64 * 8 * 256;
      g1.cnt = (unsigned*)(ws + O_BAR) + CNT_WORD0 + (L * 3 + 0) * 64; g1.bar = (unsigned*)(ws + O_BAR);
      gemm_phase_ln(g1);
    } break;
    case 7: {
      GemmP g1 = mk_gemm(XB, DM, (const u16*)(ws + O_CAQ + L * SZ_CA), DM, DM, 64, 2);
      g1.Cb = (u16*)(ws + O_CQ); g1.ldc = 512;
      gemm_phase2<EPI_BF16, EPI_BF16>(g1, gz, smem);
    } break;
    case 8: cross_attn_phase(p, L, smem); break;
    case 9: {
      GemmP g1 = mk_gemm((const u16*)(ws + O_CO), 512, (const u16*)(ws + O_CAO + L * SZ_CA), 512, 512, 64, 8);
      g1.R = nullptr; g1.ln_g = p.ln_g + (size_t)(L * 3 + 1) * DM; g1.ln_b = p.ln_b + (size_t)(L * 3 + 1) * DM;
      g1.outf = nullptr; g1.outb = (u16*)(ws + O_XB); g1.stats = (u64*)(ws + O_STATS) + (size_t)(L * 3 + 1) * 64 * 8 * 256;
      g1.cnt = (unsigned*)(ws + O_BAR) + CNT_WORD0 + (L * 3 + 1) * 64; g1.bar = (unsigned*)(ws + O_BAR);
      gemm_phase_ln(g1);
    } break;
    case 11: {
      GemmP g1 = mk_gemm(XB, DM, (const u16*)(ws + O_FFIN + L * SZ_FFIN), DM, DM, 64, 44);
      g1.Cb = (u16*)(ws + O_HID); g1.ldc = FFH;
      gemm_phase2<EPI_SWIGLU, EPI_SWIGLU>(g1, gz, smem);
    } break;
    case 12: {
      GemmP g1 = mk_gemm((const u16*)(ws + O_HID), FFH, (const u16*)(ws + O_FFOUT + L * SZ_FFOUT), FFH, FFH, 64, 8);
      g1.R = nullptr; g1.ln_g = p.ln_g + (size_t)(L * 3 + 2) * DM; g1.ln_b = p.ln_b + (size_t)(L * 3 + 2) * DM;
      g1.outf = (L == 3) ? p.out : nullptr; g1.outb = (u16*)(ws + O_XB); g1.stats = (u64*)(ws + O_STATS) + (size_t)(L * 3 + 2) * 64 * 8 * 256;
      g1.cnt = (unsigned*)(ws + O_BAR) + CNT_WORD0 + (L * 3 + 2) * 64; g1.bar = (unsigned*)(ws + O_BAR);
      gemm_phase_ln(g1);
    } break;
  }
}

typedef const Params __attribute__((address_space(4))) * KParamsP;
__global__ void __launch_bounds__(512, 2) mega(Params p_unused, int ph_lo, int ph_hi, int coop) {
  char* smem = dynsmem;
  cg::grid_group grid = cg::this_grid();
  volatile LAS unsigned* st = (volatile LAS unsigned*)(dynsmem + 131072);
  if (threadIdx.x == 0) { st[0] = 0u; st[1] = 0u; }
  __syncthreads();
#if defined(__HIP_DEVICE_COMPILE__)
  {
    KParamsP kp0 = (KParamsP)__builtin_amdgcn_kernarg_segment_ptr();
    unsigned* bar0 = (unsigned*)(kp0->ws + O_BAR);
    if (threadIdx.x == 0) (void)xb_add(&bar0[XB_XCNT(xb_xcc_id())], 1u);
  }
#endif
  for (int ph = ph_lo; ph < ph_hi; ++ph) {
    const int sp = (ph - 1) % PH_PER_LAYER, L = (ph - 1) / PH_PER_LAYER;
    const bool skip = (ph > 0) && (((L & 1) && (sp == 2 || sp == 3)) || sp == 6 || sp == 10 || sp == 13);
    if (skip) continue;
#if defined(__HIP_DEVICE_COMPILE__)
    {
      KParamsP kp = (KParamsP)__builtin_amdgcn_kernarg_segment_ptr();
      asm volatile("" : "+s"(kp));
      const Params lp = *kp;
      run_phase(lp, ph, smem);
      if (coop && ph + 1 < N_PHASES - 1) {
        if (coop == 2) grid.sync();
        else { XcdBarrier b; b.bar = (unsigned*)(lp.ws + O_BAR); b.x = xb_xcc_id(); b.st = st; xcd_barrier(b); }
      }
    }
#endif
  }
}

extern "C" void kernel_launch(void* const* d_in, const int* in_sizes, int n_in, void* d_out, int out_size, void* d_ws, size_t ws_size,
                              hipStream_t stream) {
  static int grid_blocks = 0;
  if (!grid_blocks) {
    int dev = 0, cus = 0, per_cu = 0;
    hipGetDevice(&dev);
    hipDeviceGetAttribute(&cus, hipDeviceAttributeMultiprocessorCount, dev);
    hipFuncSetAttribute((const void*)mega, hipFuncAttributeMaxDynamicSharedMemorySize, LDS_BYTES);
    hipOccupancyMaxActiveBlocksPerMultiprocessor(&per_cu, (const void*)mega, NTHR, LDS_BYTES);
    if (per_cu > 1) per_cu = 1;
    if (per_cu < 1) per_cu = 1;
    grid_blocks = cus * per_cu;
    if (ws_size < WS_TOTAL) fprintf(stderr, "kernel_launch: workspace too small: %zu < %zu\n", ws_size, (size_t)WS_TOTAL);
    fprintf(stderr, "kernel_launch: grid %d (cus %d x %d)\n", grid_blocks, cus, per_cu);
  }
  hipMemsetAsync((char*)d_ws + O_BAR, 0, 32768, stream);
  Params p{};
  p.x = (const float*)d_in[0]; p.mem = (const float*)d_in[1]; p.pos = (const int*)d_in[2];
  p.ev_w_in = (const float*)d_in[3]; p.ev_pool_w = (const float*)d_in[4]; p.ev_pool_scale = (const float*)d_in[5]; p.ev_w_out = (const float*)d_in[6];
  p.od_w_in = (const float*)d_in[7]; p.od_conv_w = (const float*)d_in[8]; p.od_forget_b = (const float*)d_in[9]; p.od_w_out = (const float*)d_in[10];
  p.ca_w_q = (const float*)d_in[11]; p.ca_w_kv = (const float*)d_in[12]; p.ca_w_o = (const float*)d_in[13];
  p.ffn_w_in = (const float*)d_in[14]; p.ffn_w_out = (const float*)d_in[15]; p.ln_g = (const float*)d_in[16]; p.ln_b = (const float*)d_in[17];
  p.out = (float*)d_out; p.ws = (char*)d_ws;
  int lo = 0, hi = N_PHASES, coop = 1;
  void* args[] = {&p, &lo, &hi, &coop};
  hipError_t e = hipLaunchCooperativeKernel((const void*)mega, dim3(grid_blocks), dim3(NTHR), args, LDS_BYTES, stream);
  if (e != hipSuccess) fprintf(stderr, "cooperative launch failed: %s (grid %d)\n", hipGetErrorString(e), grid_blocks);
}
```
